# Optimizing an MI355X kernel written in HIP

```python
import jax, jax.numpy as jnp
from jax import lax
import numpy as np

D_MODEL = 1024
BATCH = 2
SEQ = 8192
DEPTH = 1

N_META = 16
BLOCK = 128
SB_HEADS = 8
SB_HEAD_DIM = 64
SB_WIDTH = SB_HEADS * SB_HEAD_DIM
HG_HEADS = 4
HG_EXPAND = 128
HG_HEAD_DIM = 128
HG_F_WIDTH = HG_HEADS * HG_EXPAND
HG_WIDTH = HG_HEADS * HG_HEAD_DIM
MIX_WIDTH = SB_WIDTH + HG_WIDTH
IN_WIDTH = 3 * SB_WIDTH + 2 * HG_F_WIDTH + 2 * HG_WIDTH
D_FF = -(-8 * D_MODEL // (3 * 256)) * 256
RMS_EPS = 1e-6

kernel_name = "hymba_stickbreak_hgrn2_hybrid"


def rmsnorm(x, g):
    xf = x.astype(jnp.float32)
    y = xf * lax.rsqrt(jnp.mean(xf * xf, axis=-1, keepdims=True) + RMS_EPS)
    return (y * g.astype(jnp.float32)).astype(x.dtype)


def group_rmsnorm(o, g, n_heads):
    B, L, W = o.shape
    of = o.astype(jnp.float32).reshape(B, L, n_heads, W // n_heads)
    of = of * lax.rsqrt(jnp.mean(of * of, axis=-1, keepdims=True) + RMS_EPS)
    return of.reshape(B, L, W) * g.astype(jnp.float32)


def split_heads(a, n_heads):
    B, L, W = a.shape
    return a.reshape(B, L, n_heads, W // n_heads).transpose(0, 2, 1, 3)


def merge_heads(a):
    B, H, L, d = a.shape
    return a.transpose(0, 2, 1, 3).reshape(B, L, H * d)


def stick_breaking_attention(q, k, v, key_valid):
    B, H, L, Dh = q.shape
    nb = L // BLOCK
    scale = Dh ** -0.5
    q_blocks = q.reshape(B, H, nb, BLOCK, Dh).transpose(2, 0, 1, 3, 4)
    key_pos = jnp.arange(L)

    def one_block(args):
        blk, qb = args
        q_pos = blk * BLOCK + jnp.arange(BLOCK)
        z = jnp.einsum('bhqd,bhkd->bhqk', qb, k).astype(jnp.float32) * scale
        visible = (key_pos[None, :] < q_pos[:, None]) & key_valid[None, :]
        log_beta = jax.nn.log_sigmoid(z)
        log_one_minus = jnp.where(visible, jax.nn.log_sigmoid(-z), 0.0)
        later = lax.cumsum(log_one_minus, axis=3, reverse=True) - log_one_minus
        w = jnp.where(visible, jnp.exp(log_beta + later), 0.0)
        return jnp.einsum('bhqk,bhkd->bhqd', w.astype(v.dtype), v)

    out = lax.map(one_block, (jnp.arange(nb), q_blocks))
    return out.transpose(1, 2, 0, 3, 4).reshape(B, H, L, Dh)


def hgrn2_chunkwise(q, k, v, log_f):
    B, H, L, Dk = q.shape
    Dv = v.shape[-1]
    nc = L // BLOCK

    def to_chunks(a):
        return a.astype(jnp.float32).reshape(B, H, nc, BLOCK, a.shape[-1]).transpose(2, 0, 1, 3, 4)

    causal = jnp.tril(jnp.ones((BLOCK, BLOCK), dtype=bool))

    def step(S, inp):
        qc, kc, vc, gc = inp
        b = jnp.cumsum(gc, axis=2)
        diff = b[:, :, :, None, :] - b[:, :, None, :, :]
        decay = jnp.exp(jnp.where(causal[:, :, None], diff, -jnp.inf))
        scores = jnp.einsum('bhtsk,bhsk->bhts', qc[:, :, :, None, :] * decay, kc)
        o = (jnp.einsum('bhts,bhsv->bhtv', scores, vc)
             + jnp.einsum('bhtk,bhkv->bhtv', qc * jnp.exp(b), S))
        b_last = b[:, :, -1:, :]
        S = (S * jnp.exp(b_last[:, :, 0, :, None])
             + jnp.einsum('bhsk,bhsv->bhkv', kc * jnp.exp(b_last - b), vc))
        return S, o

    S0 = jnp.zeros((B, H, Dk, Dv), jnp.float32)
    _, o = lax.scan(step, S0, (to_chunks(q), to_chunks(k), to_chunks(v), to_chunks(log_f)))
    return o.transpose(1, 2, 0, 3, 4).reshape(B, H, L, Dv)


def hybrid_layer(h, key_valid, lower_bound, norm1_g, w_in, sb_norm_g, hg_norm_g, w_out,
                 norm2_g, w_gate, w_up, w_down):
    dt = h.dtype
    u = rmsnorm(h, norm1_g)
    proj = u @ w_in
    cuts = np.cumsum([SB_WIDTH, SB_WIDTH, SB_WIDTH, HG_F_WIDTH, HG_F_WIDTH, HG_WIDTH])
    sb_q, sb_k, sb_v, hg_q, hg_f, hg_i, hg_g = jnp.split(proj, cuts, axis=-1)

    o_sb = stick_breaking_attention(split_heads(sb_q, SB_HEADS), split_heads(sb_k, SB_HEADS),
                                    split_heads(sb_v, SB_HEADS), key_valid)
    o_sb = group_rmsnorm(merge_heads(o_sb), sb_norm_g, SB_HEADS)

    lb = lower_bound.astype(jnp.float32)
    log_f = jnp.logaddexp(jnp.log(lb), jnp.log1p(-lb) + jax.nn.log_sigmoid(hg_f.astype(jnp.float32)))
    hg_k = -jnp.expm1(log_f)
    valid = key_valid[None, :, None]
    log_f = jnp.where(valid, log_f, 0.0)
    hg_k = jnp.where(valid, hg_k, 0.0)
    o_hg = hgrn2_chunkwise(split_heads(hg_q, HG_HEADS), split_heads(hg_k, HG_HEADS),
                           split_heads(hg_i, HG_HEADS), split_heads(log_f, HG_HEADS))
    o_hg = group_rmsnorm(merge_heads(o_hg), hg_norm_g, HG_HEADS) * jax.nn.silu(hg_g.astype(jnp.float32))

    mix = jnp.concatenate([o_sb, o_hg], axis=-1).astype(dt) @ w_out
    h = h + mix

    u2 = rmsnorm(h, norm2_g)
    ffn = (jax.nn.silu(u2 @ w_gate) * (u2 @ w_up)) @ w_down
    return h + ffn


def setup_inputs(seed: int = 0) -> dict:
    key = jax.random.key(seed)
    ks = jax.random.split(key, 16)
    f32 = jnp.float32
    nrm = lambda k, shape, s: jax.random.normal(k, shape, f32) * s
    return {
        "x": nrm(ks[0], (BATCH, SEQ, D_MODEL), 1.0),
        "meta_tokens": nrm(ks[1], (N_META, D_MODEL), 1.0),
        "norm1_g": 1.0 + nrm(ks[2], (DEPTH, D_MODEL), 0.02),
        "w_in": nrm(ks[3], (DEPTH, D_MODEL, IN_WIDTH), D_MODEL ** -0.5),
        "sb_norm_g": 1.0 + nrm(ks[4], (DEPTH, SB_WIDTH), 0.02),
        "hg_norm_g": 1.0 + nrm(ks[5], (DEPTH, HG_WIDTH), 0.02),
        "hg_lb_logits": nrm(ks[6], (DEPTH + 1, HG_F_WIDTH), 0.5),
        "w_out": nrm(ks[7], (DEPTH, MIX_WIDTH, D_MODEL), MIX_WIDTH ** -0.5),
        "norm2_g": 1.0 + nrm(ks[8], (DEPTH, D_MODEL), 0.02),
        "w_gate": nrm(ks[9], (DEPTH, D_MODEL, D_FF), D_MODEL ** -0.5),
        "w_up": nrm(ks[10], (DEPTH, D_MODEL, D_FF), D_MODEL ** -0.5),
        "w_down": nrm(ks[11], (DEPTH, D_FF, D_MODEL), D_FF ** -0.5),
        "final_norm_g": 1.0 + nrm(ks[12], (D_MODEL,), 0.02),
    }


def reference(x, meta_tokens, norm1_g, w_in, sb_norm_g, hg_norm_g, hg_lb_logits, w_out,
              norm2_g, w_gate, w_up, w_down, final_norm_g):
    B = x.shape[0]
    pad = jnp.zeros((B, BLOCK - N_META, D_MODEL), x.dtype)
    meta = jnp.broadcast_to(meta_tokens.astype(x.dtype)[None], (B, N_META, D_MODEL))
    h = jnp.concatenate([pad, meta, x], axis=1)
    L = h.shape[1]
    key_valid = jnp.arange(L) >= (BLOCK - N_META)
    lower_bounds = jnp.cumsum(jax.nn.softmax(hg_lb_logits.astype(jnp.float32), axis=0), axis=0)
    for layer in range(DEPTH):
        h = hybrid_layer(h, key_valid, lower_bounds[layer], norm1_g[layer], w_in[layer],
                         sb_norm_g[layer], hg_norm_g[layer], w_out[layer], norm2_g[layer],
                         w_gate[layer], w_up[layer], w_down[layer])
    h = rmsnorm(h, final_norm_g)
    return h[:, BLOCK:, :]
```

```cpp
#include <hip/hip_runtime.h>
#include <hip/hip_cooperative_groups.h>
#include <cstdio>
#include <cstdint>
namespace cg = cooperative_groups;
namespace pg8 {
#define PG8_LAS __attribute__((address_space(3)))
typedef unsigned short bf16_t;
typedef short bf16x8 __attribute__((ext_vector_type(8)));
typedef float f32x4 __attribute__((ext_vector_type(4)));
typedef unsigned u32x4 __attribute__((ext_vector_type(4)));
constexpr int BM = 256, BK = 64, HALF = 128, HTB = HALF * BK * 2  , STAGE_BYTES = 8 * HTB, NXCD = 8, WGM = 8;

__host__ __device__ __forceinline__ int lds_byte(int r, int c) { const int st = (r >> 4) * 2 + (c >> 5), rr = r & 15, cc = c & 31, ob = rr * 64 + cc * 2; return st * 1024 + (ob ^ (((ob >> 9) & 1) << 5)); }
__host__ __device__ __forceinline__ void stage_rc(int b, int& R, int& C) { const int st = b / 1024, sb = b % 1024, swz = sb ^ (((sb >> 9) & 1) << 5); R = (st >> 1) * 16 + swz / 64; C = (st & 1) * 32 + (swz % 64) / 2; }
__host__ __device__ __forceinline__ int perm32(int rho) { const int n = rho >> 4, i = rho & 15; return 8 * (i >> 2) + 4 * n + (i & 3); }

struct Unit { int pm, pn; };
struct Gemm { const bf16_t* A; const bf16_t* Bt; int M, N, K; };

struct StaticOrder {
    int nM, nN, nwg, G, c, rep;
    __host__ __device__ void init(int M, int N, int G_, int c_) { nM = M / BM; nN = N / BM; nwg = nM * nN; G = G_; c = c_; rep = 1; }
    __host__ __device__ bool next(int i, Unit& u) const {
        const long L = (long)i * G + c; if (L >= (long)nwg * rep) return false;
        int wgid = (int)(L % nwg); { const int q = nwg / NXCD, r = nwg % NXCD, xcd = wgid % NXCD, off = wgid / NXCD; wgid = (xcd < r ? xcd * (q + 1) : r * (q + 1) + (xcd - r) * q) + off; }
        const int nig = WGM * nN, gid = wgid / nig, fm = gid * WGM, gsz = (nM - fm) < WGM ? (nM - fm) : WGM;
        u.pm = fm + ((wgid % nig) % gsz); u.pn = (wgid % nig) / gsz; return true;
    }
    __device__ __forceinline__ void a_ready(const Unit&) const {}
    __device__ __forceinline__ void done(const Unit&) const {}
};

__device__ __forceinline__ unsigned cvt_pk_bf16(float lo, float hi) { unsigned r; asm volatile("v_cvt_pk_bf16_f32 %0, %1, %2" : "=v"(r) : "v"(lo), "v"(hi)); return r; }
typedef float f32x2 __attribute__((ext_vector_type(2)));
typedef float f32x2_t __attribute__((ext_vector_type(2))); typedef __bf16 bf16x2_t __attribute__((ext_vector_type(2)));
__device__ __forceinline__ unsigned cvtpk(float lo, float hi) { f32x2_t v = {lo, hi}; bf16x2_t b = __builtin_convertvector(v, bf16x2_t); return __builtin_bit_cast(unsigned, b); }
typedef unsigned u32x2 __attribute__((ext_vector_type(2)));

struct EpiProj {
    static constexpr bool PERM = true, AFTER_DRAIN = false;
    bf16_t* proj; float* logf; const float* lbl;
    __device__ __forceinline__ void operator()(const f32x4 (&acc)[2][2][4][2], const Unit& u, int wr, int wc, int fr, int fq) const {
        const int row0 = u.pm * BM + wr * 64 + fr, colt = u.pn * BM, seg = colt >> 9;
        if (seg != 4) {
            const float sc = (seg == 0) ? 0.18033688011112042f : 1.f;
            const int pc = (colt < 2048 ? colt : colt - 512) + wc * 32 + 8 * fq;
#pragma unroll
            for (int ai = 0; ai < 2; ++ai)
#pragma unroll
                for (int m = 0; m < 4; ++m) { bf16_t* rowp = proj + (size_t)(row0 + ai * HALF + m * 16) * 3072 + pc;
#pragma unroll
                    for (int bj = 0; bj < 2; ++bj) { const f32x4 v0 = acc[ai][bj][m][0] * sc, v1 = acc[ai][bj][m][1] * sc;
                        u32x4 w; w.x = cvtpk(v0[0], v0[1]); w.y = cvtpk(v0[2], v0[3]); w.z = cvtpk(v1[0], v1[1]); w.w = cvtpk(v1[2], v1[3]);
                        *(u32x4*)(rowp + bj * HALF) = w; } }
        } else {
            const int c0 = colt - 2048 + wc * 32 + 8 * fq;
            float oml[2][8];
#pragma unroll
            for (int bj = 0; bj < 2; ++bj)
#pragma unroll
                for (int e = 0; e < 8; ++e) { const int c = c0 + bj * HALF + e; oml[bj][e] = 1.0f / (1.0f + __expf(lbl[c] - lbl[512 + c])); }
#pragma unroll
            for (int ai = 0; ai < 2; ++ai)
#pragma unroll
                for (int m = 0; m < 4; ++m) { const int row = row0 + ai * HALF + m * 16; const bool valid = (row % 8320) >= 112; float* rowp = logf + (size_t)row * 512 + c0;
#pragma unroll
                    for (int bj = 0; bj < 2; ++bj)
#pragma unroll
                        for (int n = 0; n < 2; ++n) { f32x4 o;
#pragma unroll
                            for (int e = 0; e < 4; ++e) { const float f = acc[ai][bj][m][n][e]; const float k = oml[bj][4 * n + e] * __builtin_amdgcn_rcpf(1.0f + __expf(f)); o[e] = valid ? __logf(1.0f - k) : 0.f; }
                            *(f32x4*)(rowp + bj * HALF + 4 * n) = o; } }
        }
    }
};

struct EpiResid {
    static constexpr bool PERM = false, AFTER_DRAIN = true;
    const float* base; float* out; bf16_t* outb; float* ss;
    __device__ __forceinline__ void fused(f32x4 (&acc)[2][2][4][2], const Unit& u, int wr, int wc, int fr, int fq, PG8_LAS unsigned char* lds, int wid, int lane) const {
        PG8_LAS float* P = (PG8_LAS float*)lds;
        const int col0 = u.pn * BM + wc * 32 + 4 * fq;
#pragma unroll
        for (int ai = 0; ai < 2; ++ai) {
            f32x4 pre[4][2][2];
#pragma unroll
            for (int m = 0; m < 4; ++m) { const size_t off = (size_t)(u.pm * BM + ai * HALF + wr * 64 + m * 16 + fr) * 1024 + col0;
#pragma unroll
                for (int bj = 0; bj < 2; ++bj)
#pragma unroll
                    for (int n = 0; n < 2; ++n) pre[m][bj][n] = *(const f32x4*)(base + off + bj * HALF + n * 16); }
            asm volatile("" ::: "memory");
#pragma unroll
            for (int m = 0; m < 4; ++m) { const int r = ai * HALF + wr * 64 + m * 16 + fr; const size_t off = (size_t)(u.pm * BM + r) * 1024 + col0; float s = 0.f;
#pragma unroll
                for (int bj = 0; bj < 2; ++bj)
#pragma unroll
                    for (int n = 0; n < 2; ++n) { const f32x4 o = pre[m][bj][n] + acc[ai][bj][m][n];
                        if (out) *(f32x4*)(out + off + bj * HALF + n * 16) = o;
                        s += (o[0] * o[0] + o[1] * o[1]) + (o[2] * o[2] + o[3] * o[3]);
                        if (outb) { u32x2 w; w.x = cvtpk(o[0], o[1]); w.y = cvtpk(o[2], o[3]); *(u32x2*)(outb + off + bj * HALF + n * 16) = w; } }
                s += __shfl_xor(s, 16); s += __shfl_xor(s, 32);
                if (fq == 0) P[r * 4 + wc] = s; }
            asm volatile("" ::: "memory");
        }
        __syncthreads();
        const int tid = wid * 64 + lane;
        if (tid < 256) { const float t = (P[tid * 4 + 0] + P[tid * 4 + 1]) + (P[tid * 4 + 2] + P[tid * 4 + 3]); ss[(size_t)(u.pm * BM + tid) * 4 + u.pn] = t; }
    }
};

struct EpiSwiglu {
    static constexpr bool PERM = true, AFTER_DRAIN = false;
    bf16_t* hid; const float* ss;
    __device__ __forceinline__ void operator()(const f32x4 (&acc)[2][2][4][2], const Unit& u, int wr, int wc, int fr, int fq) const {
        const int row0 = u.pm * BM + wr * 64 + fr, col0 = u.pn * HALF + wc * 32 + 8 * fq;
#pragma unroll
        for (int ai = 0; ai < 2; ++ai)
#pragma unroll
            for (int m = 0; m < 4; ++m) { const int row = row0 + ai * HALF + m * 16; const f32x4 s4 = *(const f32x4*)(ss + (size_t)row * 4);
                const float rstd = __builtin_amdgcn_rsqf(((s4[0] + s4[1]) + (s4[2] + s4[3])) * (1.0f / 1024.0f) + 1e-6f);
                float a[8];
#pragma unroll
                for (int n = 0; n < 2; ++n)
#pragma unroll
                    for (int e = 0; e < 4; ++e) { const float g = acc[ai][0][m][n][e] * rstd, up = acc[ai][1][m][n][e] * rstd; a[4 * n + e] = g * __builtin_amdgcn_rcpf(1.0f + __expf(-g)) * up; }
                u32x4 w; w.x = cvtpk(a[0], a[1]); w.y = cvtpk(a[2], a[3]); w.z = cvtpk(a[4], a[5]); w.w = cvtpk(a[6], a[7]);
                *(u32x4*)(hid + (size_t)row * 2816 + col0) = w; }
    }
};

struct EpiFinal {
    static constexpr bool PERM = false, AFTER_DRAIN = true;
    const bf16_t* base; float* out; float* ss; unsigned* cnt; const float* gf;
    __device__ __forceinline__ void fused(f32x4 (&acc)[2][2][4][2], const Unit& u, int wr, int wc, int fr, int fq, PG8_LAS unsigned char* lds, int wid, int lane) const {
        PG8_LAS float* P = (PG8_LAS float*)lds;
        PG8_LAS float* S = (PG8_LAS float*)(lds + 4096);
        const int col0 = u.pn * BM + wc * 32 + 4 * fq;
        u32x2 pre[2][4][2][2];
#pragma unroll
        for (int ai = 0; ai < 2; ++ai)
#pragma unroll
            for (int m = 0; m < 4; ++m) { const size_t off = (size_t)(u.pm * BM + ai * HALF + wr * 64 + m * 16 + fr) * 1024 + col0;
#pragma unroll
                for (int bj = 0; bj < 2; ++bj)
#pragma unroll
                    for (int n = 0; n < 2; ++n) pre[ai][m][bj][n] = *(const u32x2*)(base + off + bj * HALF + n * 16); }
        asm volatile("" ::: "memory");
#pragma unroll
        for (int ai = 0; ai < 2; ++ai)
#pragma unroll
            for (int m = 0; m < 4; ++m) { const int r = ai * HALF + wr * 64 + m * 16 + fr; float s = 0.f;
#pragma unroll
                for (int bj = 0; bj < 2; ++bj)
#pragma unroll
                    for (int n = 0; n < 2; ++n) { const u32x2 bw = pre[ai][m][bj][n];
                        const f32x4 bs = (f32x4){__uint_as_float(bw.x << 16), __uint_as_float(bw.x & 0xffff0000u), __uint_as_float(bw.y << 16), __uint_as_float(bw.y & 0xffff0000u)}; const f32x4 o = bs + acc[ai][bj][m][n];
                        acc[ai][bj][m][n] = o; s += (o[0] * o[0] + o[1] * o[1]) + (o[2] * o[2] + o[3] * o[3]); }
                s += __shfl_xor(s, 16); s += __shfl_xor(s, 32);
                if (fq == 0) P[r * 4 + wc] = s; }
        __syncthreads();
        const int tid = wid * 64 + lane;
        float* slot = ss + (size_t)(u.pm * BM + (tid & 255)) * 4;
        if (tid < 256) { const float t = (P[tid * 4 + 0] + P[tid * 4 + 1]) + (P[tid * 4 + 2] + P[tid * 4 + 3]); __hip_atomic_store(slot + u.pn, t, __ATOMIC_RELAXED, __HIP_MEMORY_SCOPE_AGENT); }
        asm volatile("s_waitcnt vmcnt(0)" ::: "memory");
        unsigned* c = cnt + 64 * u.pm;
        if (lane == 0) __hip_atomic_fetch_add(c, 1u, __ATOMIC_RELAXED, __HIP_MEMORY_SCOPE_AGENT);
        if (wid == 0) {
            unsigned sp = 0;
            while ((unsigned)__builtin_amdgcn_readfirstlane(__hip_atomic_load(c, __ATOMIC_RELAXED, __HIP_MEMORY_SCOPE_AGENT)) < 32u) { __builtin_amdgcn_s_sleep(2); if (++sp > (1u << 22)) break; }
            __builtin_amdgcn_fence(__ATOMIC_ACQUIRE, "agent");
        }
        asm volatile("s_waitcnt vmcnt(0) lgkmcnt(0)" ::: "memory");
        __syncthreads();
        if (tid < 256) { float t4[4];
#pragma unroll
            for (int t = 0; t < 4; ++t) t4[t] = __hip_atomic_load(slot + t, __ATOMIC_RELAXED, __HIP_MEMORY_SCOPE_AGENT);
            S[tid] = 1.0f / sqrtf(((t4[0] + t4[1]) + (t4[2] + t4[3])) * (1.0f / 1024.0f) + 1e-6f); }
        __syncthreads();
#pragma unroll
        for (int ai = 0; ai < 2; ++ai)
#pragma unroll
            for (int m = 0; m < 4; ++m) { const int r = ai * HALF + wr * 64 + m * 16 + fr; const float rs = S[r]; const size_t off = (size_t)(u.pm * BM + r) * 1024 + col0;
#pragma unroll
                for (int bj = 0; bj < 2; ++bj)
#pragma unroll
                    for (int n = 0; n < 2; ++n) { const f32x4 g4 = *(const f32x4*)(gf + col0 + bj * HALF + n * 16); *(f32x4*)(out + off + bj * HALF + n * 16) = acc[ai][bj][m][n] * rs * g4; } }
    }
};
template <class Epi, class Sched, bool ALIGN_EPI = false, bool SP2 = false>
__device__ __forceinline__ void gemm_phase(PG8_LAS unsigned char* lds, const Gemm g, const Sched& S, const Epi& E) {
    int tid_ = threadIdx.x; asm volatile("" : "+v"(tid_));
    const int tid = tid_, wid = __builtin_amdgcn_readfirstlane(tid >> 6), lane = tid & 63, wr = wid >> 2, wc = wid & 3, fr = lane & 15, fq = lane >> 4;
    const int K = g.K, nt = K / BK;
    unsigned voffA[2], voffB[2];
#pragma unroll
    for (int i = 0; i < 2; ++i) { int R, C; stage_rc(tid * 16 + i * 8192, R, C); const int Rb = Epi::PERM ? ((R & ~31) + perm32(R & 31)) : R;
        voffA[i] = (unsigned)(R * K + C) * 2u; voffB[i] = (unsigned)(Rb * K + C) * 2u; }
    const size_t kstep = (size_t)(BK * 2);
    const size_t hstep = (size_t)HALF * K * 2;
    const size_t tstep = 2 * hstep;
    const unsigned ldsw = (unsigned)wid * 1024u;
    const int aoff = lds_byte(wr * 64 + fr, fq * 8), boff = lds_byte(wc * 32 + fr, fq * 8);
#define PG8_SA(b, h) (((b) * 2 + (h)) * HTB)
#define PG8_SB(b, h) ((4 + (b) * 2 + (h)) * HTB)
#define PG8_STAGE(bufoff, gbase, voff) do { _Pragma("unroll") for (int _i = 0; _i < 2; ++_i) \
        __builtin_amdgcn_global_load_lds((const unsigned*)((const char*)(gbase) + (voff)[_i]), (PG8_LAS unsigned*)(lds + (bufoff) + ldsw + _i * 8192), 16, 0, 0); } while (0)
#define PG8_LDA(dst, b, h) do { _Pragma("unroll") for (int m = 0; m < 4; ++m) _Pragma("unroll") for (int k = 0; k < 2; ++k) dst[m][k] = *(const PG8_LAS bf16x8*)(lds + PG8_SA(b, h) + aoff + m * 2048 + k * 1024); } while (0)
#define PG8_LDB(dst, b, h) do { _Pragma("unroll") for (int n = 0; n < 2; ++n) _Pragma("unroll") for (int k = 0; k < 2; ++k) dst[n][k] = *(const PG8_LAS bf16x8*)(lds + PG8_SB(b, h) + boff + n * 2048 + k * 1024); } while (0)
#define PG8_MMA(ai, bj, At, Bt) do { __builtin_amdgcn_s_setprio(1); _Pragma("unroll") for (int m = 0; m < 4; ++m) _Pragma("unroll") for (int n = 0; n < 2; ++n) _Pragma("unroll") for (int k = 0; k < 2; ++k) \
        acc[ai][bj][m][n] = __builtin_amdgcn_mfma_f32_16x16x32_bf16(Bt[n][k], At[m][k], acc[ai][bj][m][n], 0, 0, 0); __builtin_amdgcn_s_setprio(0); } while (0)
#define PG8_WAIT_V(n) asm volatile("s_waitcnt vmcnt(" #n ")" ::: "memory")
#define PG8_WAIT_L(n) asm volatile("s_waitcnt lgkmcnt(" #n ")" ::: "memory")
#define PG8_BAR __builtin_amdgcn_s_barrier()
#define PG8_SCHED __builtin_amdgcn_sched_barrier(0)
    Unit cur, nxt; int ui = 0;
    if (!S.next(0, cur)) return;
    f32x4 acc[2][2][4][2];
#pragma unroll
    for (int a = 0; a < 2; ++a)
#pragma unroll
        for (int b = 0; b < 2; ++b)
#pragma unroll
            for (int m = 0; m < 4; ++m)
#pragma unroll
                for (int n = 0; n < 2; ++n) acc[a][b][m][n] = (f32x4){0.f, 0.f, 0.f, 0.f};
    bf16x8 At[4][2], B0[2][2], B1[2][2];
    const char* cA = (const char*)g.A + (size_t)cur.pm * tstep; const char* cB = (const char*)g.Bt + (size_t)cur.pn * tstep;
    S.a_ready(cur);
    if constexpr (SP2) {
        PG8_STAGE(PG8_SB(0, 0), cB, voffB); PG8_STAGE(PG8_SB(0, 1), cB + hstep, voffB); PG8_STAGE(PG8_SA(0, 0), cA, voffA); PG8_STAGE(PG8_SA(0, 1), cA + hstep, voffA);
        if (wr == 1) PG8_BAR;
        PG8_WAIT_V(2); PG8_BAR;
        PG8_STAGE(PG8_SB(1, 0), cB + kstep, voffB); PG8_STAGE(PG8_SA(1, 0), cA + kstep, voffA); PG8_STAGE(PG8_SB(1, 1), cB + hstep + kstep, voffB);
        PG8_WAIT_V(6); PG8_BAR;
    } else {
        PG8_STAGE(PG8_SB(0, 0), cB, voffB); PG8_STAGE(PG8_SA(0, 0), cA, voffA); PG8_STAGE(PG8_SB(0, 1), cB + hstep, voffB); PG8_STAGE(PG8_SA(0, 1), cA + hstep, voffA);
        if (wr == 1) PG8_BAR;
        PG8_WAIT_V(4); PG8_BAR;
        PG8_STAGE(PG8_SB(1, 0), cB + kstep, voffB); PG8_STAGE(PG8_SA(1, 0), cA + kstep, voffA); PG8_STAGE(PG8_SB(1, 1), cB + hstep + kstep, voffB);
        PG8_WAIT_V(6); PG8_BAR;
    }
    for (;;) {
        const bool has_next = S.next(ui + 1, nxt);
        const char* nA = has_next ? (const char*)g.A + (size_t)nxt.pm * tstep : cA; const char* nB = has_next ? (const char*)g.Bt + (size_t)nxt.pn * tstep : cB;
        for (int t = 0; t < nt; t += 2) {
            const bool last = (t == nt - 2);
            const char* a1 = cA + (size_t)(t + 1) * kstep;
            const char* a2 = last ? nA : cA + (size_t)(t + 2) * kstep; const char* b2 = last ? nB : cB + (size_t)(t + 2) * kstep;
            const char* a3 = a2 + kstep; const char* b3 = b2 + kstep;
            if (last && has_next) S.a_ready(nxt);
            if constexpr (SP2) {
            PG8_LDB(B0, 0, 0); PG8_LDB(B1, 0, 1); PG8_SCHED; PG8_LDA(At, 0, 0); PG8_STAGE(PG8_SA(1, 1), a1 + hstep, voffA);
            PG8_WAIT_V(8); PG8_WAIT_L(0); PG8_BAR; PG8_MMA(0, 0, At, B0); PG8_MMA(0, 1, At, B1); PG8_BAR; PG8_SCHED;
            PG8_LDA(At, 0, 1); PG8_STAGE(PG8_SB(0, 0), b2, voffB); PG8_STAGE(PG8_SB(0, 1), b2 + hstep, voffB); PG8_STAGE(PG8_SA(0, 0), a2, voffA);
            PG8_WAIT_V(8); PG8_WAIT_L(0); PG8_BAR; PG8_MMA(1, 0, At, B0); PG8_MMA(1, 1, At, B1); PG8_BAR; PG8_SCHED;
            PG8_LDB(B0, 1, 0); PG8_LDB(B1, 1, 1); PG8_SCHED; PG8_LDA(At, 1, 0); PG8_STAGE(PG8_SA(0, 1), a2 + hstep, voffA);
            PG8_WAIT_V(8); PG8_WAIT_L(0); PG8_BAR; PG8_MMA(0, 0, At, B0); PG8_MMA(0, 1, At, B1); PG8_BAR; PG8_SCHED;
            PG8_LDA(At, 1, 1); PG8_STAGE(PG8_SB(1, 0), b3, voffB); PG8_STAGE(PG8_SB(1, 1), b3 + hstep, voffB); PG8_STAGE(PG8_SA(1, 0), a3, voffA);
            PG8_WAIT_V(8); PG8_WAIT_L(0); PG8_BAR; PG8_MMA(1, 0, At, B0); PG8_MMA(1, 1, At, B1); PG8_BAR; PG8_SCHED;
            } else {
            PG8_LDB(B0, 0, 0); PG8_SCHED; PG8_LDA(At, 0, 0); PG8_STAGE(PG8_SA(1, 1), a1 + hstep, voffA);
            PG8_WAIT_L(8); PG8_BAR; PG8_WAIT_L(0); PG8_MMA(0, 0, At, B0); PG8_BAR; PG8_SCHED;
            PG8_LDB(B1, 0, 1); PG8_STAGE(PG8_SB(0, 0), b2, voffB);
            PG8_BAR; PG8_WAIT_L(0); PG8_MMA(0, 1, At, B1); PG8_BAR;
            PG8_LDA(At, 0, 1); PG8_STAGE(PG8_SA(0, 0), a2, voffA);
            PG8_BAR; PG8_WAIT_L(0); PG8_MMA(1, 0, At, B0); PG8_BAR; PG8_SCHED;
            PG8_STAGE(PG8_SB(0, 1), b2 + hstep, voffB);
            PG8_WAIT_V(6); PG8_BAR; PG8_MMA(1, 1, At, B1); PG8_BAR;
            PG8_LDB(B0, 1, 0); PG8_SCHED; PG8_LDA(At, 1, 0); PG8_STAGE(PG8_SA(0, 1), a2 + hstep, voffA);
            PG8_WAIT_L(8); PG8_BAR; PG8_WAIT_L(0); PG8_MMA(0, 0, At, B0); PG8_BAR; PG8_SCHED;
            PG8_LDB(B1, 1, 1); PG8_STAGE(PG8_SB(1, 0), b3, voffB);
            PG8_BAR; PG8_WAIT_L(0); PG8_MMA(0, 1, At, B1); PG8_BAR;
            PG8_LDA(At, 1, 1); PG8_STAGE(PG8_SA(1, 0), a3, voffA);
            PG8_BAR; PG8_WAIT_L(0); PG8_MMA(1, 0, At, B0); PG8_BAR; PG8_SCHED;
            PG8_STAGE(PG8_SB(1, 1), b3 + hstep, voffB);
            PG8_WAIT_V(6); PG8_BAR; PG8_MMA(1, 1, At, B1); PG8_BAR;
            }
        }
        if constexpr (ALIGN_EPI) { if (wr == 0) PG8_BAR; }
        if constexpr (!Epi::AFTER_DRAIN) { E(acc, cur, wr, wc, fr, fq); S.done(cur); }
        if (!has_next) break;
#pragma unroll
        for (int a = 0; a < 2; ++a)
#pragma unroll
            for (int b = 0; b < 2; ++b)
#pragma unroll
                for (int m = 0; m < 4; ++m)
#pragma unroll
                    for (int n = 0; n < 2; ++n) acc[a][b][m][n] = (f32x4){0.f, 0.f, 0.f, 0.f};
        cur = nxt; cA = nA; cB = nB; ++ui;
        if constexpr (ALIGN_EPI) { if (wr == 1) PG8_BAR; }
    }
    PG8_WAIT_V(0);
    if constexpr (!ALIGN_EPI) { if (wr == 0) PG8_BAR; }
    PG8_BAR;
    if constexpr (Epi::AFTER_DRAIN) { E.fused(acc, cur, wr, wc, fr, fq, lds, wid, lane); S.done(cur); }
#undef PG8_SA
#undef PG8_SB
#undef PG8_STAGE
#undef PG8_LDA
#undef PG8_LDB
#undef PG8_MMA
#undef PG8_WAIT_V
#undef PG8_WAIT_L
#undef PG8_BAR
#undef PG8_SCHED
}
}

using pg8::bf16_t; using pg8::bf16x8; using pg8::f32x4; using pg8::u32x4; using pg8::u32x2; using pg8::cvtpk;
typedef float f32x16 __attribute__((ext_vector_type(16)));
constexpr int D = 1024, SEQ = 8192, LP = 8320, NB = 2, MP = NB * LP, MX = NB * SEQ, INW = 3584, PW = 3072, FF = 2816;
constexpr float EPS = 1e-6f;
constexpr size_t MiB = 1u << 20;
constexpr size_t WS_WIN = 1 * MiB, WS_WOUT = 8 * MiB, WS_WGU = 10 * MiB, WS_WDN = 21 * MiB;
constexpr size_t WS_U = 27 * MiB;
constexpr size_t WS_LOGF = 60 * MiB;
constexpr size_t WS_UT = 93 * MiB;
constexpr size_t WS_SPREV = 31 * MiB;
constexpr size_t WS_MIX = 110 * MiB;
constexpr size_t WS_SMALL = 142 * MiB;
constexpr size_t WS_PROJ = 144 * MiB;
constexpr int LDS_BYTES = 147456;
constexpr int NWG = 256;

__device__ __forceinline__ float bflo(unsigned w) { return __uint_as_float(w << 16); }
__device__ __forceinline__ float bfhi(unsigned w) { return __uint_as_float(w & 0xffff0000u); }
__device__ __forceinline__ float wave_sum(float v) {
#pragma unroll
    for (int o = 1; o < 64; o <<= 1) v += __shfl_xor(v, o);
    return v;
}
#define LDS_WAIT() asm volatile("s_waitcnt lgkmcnt(0)" ::: "memory")

template <int MODE> __device__ __forceinline__ void p0_transpose_item(const float* W, int K, int N, bf16_t* WT, const float* gk, float* scr, int item, int lane) {
    const int nblk = N / 32, kb = item / nblk, nb = item % nblk, k0 = 64 * kb, n0 = 32 * nb;
    float wv[32];
#pragma unroll
    for (int i = 0; i < 32; ++i) { const int kk = 2 * i + (lane >> 5); wv[i] = W[(size_t)(k0 + kk) * N + n0 + (lane & 31)]; }
#pragma unroll
    for (int i = 0; i < 32; ++i) { const int kk = 2 * i + (lane >> 5); float w = wv[i]; if (gk) w *= gk[k0 + kk]; scr[kk * 33 + (lane & 31)] = w; }
    LDS_WAIT();
    const int c = lane & 7;
#pragma unroll
    for (int j = 0; j < 4; ++j) { const int n = (lane >> 3) + 8 * j; const float* s = scr + (8 * c) * 33 + n;
        u32x4 o; o.x = cvtpk(s[0 * 33], s[1 * 33]); o.y = cvtpk(s[2 * 33], s[3 * 33]); o.z = cvtpk(s[4 * 33], s[5 * 33]); o.w = cvtpk(s[6 * 33], s[7 * 33]);
        const int nn = n0 + n; const int drow = (MODE == 0) ? nn : (((nn >> 7) << 8) + (nn & 127) + (MODE == 2 ? 128 : 0));
        *(u32x4*)(WT + (size_t)drow * K + k0 + 8 * c) = o; }
    LDS_WAIT();
}
__device__ __forceinline__ void u_rows4(int m0, const float* x, const float* meta, const float* g, bf16_t* U, int lane) {
    f32x4 v[4][4]; float s[4];
#pragma unroll
    for (int rr = 0; rr < 4; ++rr) { const int m = m0 + rr, b = m / LP, pos = m % LP;
        const float* src = pos < 112 ? nullptr : (pos < 128 ? meta + (size_t)(pos - 112) * D : x + ((size_t)b * SEQ + pos - 128) * D);
#pragma unroll
        for (int j = 0; j < 4; ++j) v[rr][j] = src ? ((const f32x4*)src)[lane + 64 * j] : (f32x4){0.f, 0.f, 0.f, 0.f}; }
#pragma unroll
    for (int rr = 0; rr < 4; ++rr) { float t = 0.f;
#pragma unroll
        for (int j = 0; j < 4; ++j) t += (v[rr][j][0] * v[rr][j][0] + v[rr][j][1] * v[rr][j][1]) + (v[rr][j][2] * v[rr][j][2] + v[rr][j][3] * v[rr][j][3]);
        s[rr] = t; }
#pragma unroll
    for (int o = 1; o < 64; o <<= 1) {
#pragma unroll
        for (int rr = 0; rr < 4; ++rr) s[rr] += __shfl_xor(s[rr], o); }
#pragma unroll
    for (int rr = 0; rr < 4; ++rr) { const float rstd = __builtin_amdgcn_rsqf(s[rr] * (1.0f / D) + EPS); bf16_t* orow = U + (size_t)(m0 + rr) * D;
#pragma unroll
        for (int j = 0; j < 4; ++j) { const f32x4 g4 = ((const f32x4*)g)[lane + 64 * j]; const f32x4 o = v[rr][j] * rstd * g4;
            u32x2 w; w.x = cvtpk(o[0], o[1]); w.y = cvtpk(o[2], o[3]); ((u32x2*)orow)[lane + 64 * j] = w; } }
}

__device__ __forceinline__ void stage_vT(const bf16_t* PROJ, size_t m0, int h, bf16_t* vT) {
    const int tid = threadIdx.x;
#pragma unroll
    for (int ii = 0; ii < 2; ++ii) { const int it = tid + 512 * ii, sp = it & 63, vc = it >> 6;
        const bf16_t* src = PROJ + (m0 + 2 * sp) * PW + 2048 + h * 128 + vc * 8;
        const u32x4 d0 = *(const u32x4*)src, d1 = *(const u32x4*)(src + PW);
#pragma unroll
        for (int j = 0; j < 4; ++j) { *(unsigned*)(vT + (vc * 8 + 2 * j) * 136 + 2 * sp) = (d0[j] & 0xffffu) | (d1[j] << 16);
            *(unsigned*)(vT + (vc * 8 + 2 * j + 1) * 136 + 2 * sp) = (d0[j] >> 16) | (d1[j] & 0xffff0000u); } }
}
__device__ __forceinline__ f32x4 exp4(f32x4 v) { return (f32x4){__expf(v[0]), __expf(v[1]), __expf(v[2]), __expf(v[3])}; }
__device__ __forceinline__ void hg_local_unit(int unit, bool light, const float* LOGF, const bf16_t* PROJ, bf16_t* KH, bf16_t* QT, bf16_t* QB, float* DB, bf16_t* UT, float* DEC, unsigned char* lds) {
    const int tid = threadIdx.x, lane = tid & 63, w = __builtin_amdgcn_readfirstlane(tid >> 6);
    const int bh = unit / 65, c = unit % 65, b = bh >> 2, h = bh & 3;
    const size_t m0 = (size_t)b * LP + (size_t)c * 128;
    bf16_t* kT = (bf16_t*)lds;
    bf16_t* vT = (bf16_t*)(lds + 34816);
    float* tot = (float*)(lds + 69632);
    const int kq = tid & 31, rg = tid >> 5;
    if (!light) stage_vT(PROJ, m0, h, vT);
    const size_t rbase = (m0 + rg * 8) * 512 + h * 128 + 4 * kq;
    f32x4 pre[8], kk[8]; u32x2 qw[8]; f32x4 run = (f32x4){0.f, 0.f, 0.f, 0.f};
#pragma unroll
    for (int i = 0; i < 8; ++i) pre[i] = *(const f32x4*)(LOGF + rbase + (size_t)i * 512);
#pragma unroll
    for (int i = 0; i < 8; ++i) qw[i] = *(const u32x2*)(PROJ + (m0 + rg * 8 + i) * PW + 1536 + h * 128 + 4 * kq);
#pragma unroll
    for (int i = 0; i < 8; ++i) { const f32x4 lf = pre[i]; run += lf; pre[i] = run; kk[i] = 1.0f - exp4(lf); }
    *(f32x4*)(tot + rg * 128 + 4 * kq) = run;
    __syncthreads();
    f32x4 off = (f32x4){0.f, 0.f, 0.f, 0.f}, Bj = off, blast = off; const int g0 = rg & ~1;
#pragma unroll
    for (int g = 0; g < 16; ++g) { const f32x4 t = *(const f32x4*)(tot + g * 128 + 4 * kq); if (g < rg) off += t; if (g < g0) Bj += t; blast += t; }
    const f32x4 Ej = Bj + *(const f32x4*)(tot + g0 * 128 + 4 * kq) + *(const f32x4*)(tot + (g0 + 1) * 128 + 4 * kq);
    const f32x4 cE = exp4(blast - Ej);
    u32x4 ktw[4];
#pragma unroll
    for (int i = 0; i < 8; i += 2) {
        const f32x4 b0 = off + pre[i], b1 = off + pre[i + 1];
        const f32x4 kh0 = kk[i] * exp4(Ej - b0), kh1 = kk[i + 1] * exp4(Ej - b1);
        const f32x4 q0 = (f32x4){bflo(qw[i].x), bfhi(qw[i].x), bflo(qw[i].y), bfhi(qw[i].y)}, q1 = (f32x4){bflo(qw[i + 1].x), bfhi(qw[i + 1].x), bflo(qw[i + 1].y), bfhi(qw[i + 1].y)};
        const f32x4 qt0 = q0 * exp4(b0 - Bj), qt1 = q1 * exp4(b1 - Bj), qb0 = q0 * exp4(b0), qb1 = q1 * exp4(b1);
        u32x2 s;
        s.x = cvtpk(kh0[0], kh0[1]); s.y = cvtpk(kh0[2], kh0[3]); *(u32x2*)(KH + rbase + (size_t)i * 512) = s;
        s.x = cvtpk(kh1[0], kh1[1]); s.y = cvtpk(kh1[2], kh1[3]); *(u32x2*)(KH + rbase + (size_t)(i + 1) * 512) = s;
        s.x = cvtpk(qt0[0], qt0[1]); s.y = cvtpk(qt0[2], qt0[3]); *(u32x2*)(QT + rbase + (size_t)i * 512) = s;
        s.x = cvtpk(qt1[0], qt1[1]); s.y = cvtpk(qt1[2], qt1[3]); *(u32x2*)(QT + rbase + (size_t)(i + 1) * 512) = s;
        s.x = cvtpk(qb0[0], qb0[1]); s.y = cvtpk(qb0[2], qb0[3]); *(u32x2*)(QB + rbase + (size_t)i * 512) = s;
        s.x = cvtpk(qb1[0], qb1[1]); s.y = cvtpk(qb1[2], qb1[3]); *(u32x2*)(QB + rbase + (size_t)(i + 1) * 512) = s;
        const f32x4 u0 = kh0 * cE, u1 = kh1 * cE;
#pragma unroll
        for (int cc = 0; cc < 4; ++cc) ktw[cc][i >> 1] = cvtpk(u0[cc], u1[cc]);
    }
#pragma unroll
    for (int cc = 0; cc < 4; ++cc) *(u32x4*)(kT + (4 * kq + cc) * 136 + rg * 8) = ktw[cc];
    if ((rg & 1) == 0) *(f32x4*)(DB + (size_t)unit * 1024 + (rg >> 1) * 128 + 4 * kq) = exp4(Ej - Bj);
    if (rg == 0) *(f32x4*)(DEC + unit * 128 + 4 * kq) = exp4(blast);
    __syncthreads();
    if (light) return;
    const int r = lane & 15, quad = lane >> 4;
    f32x4 acc[8];
#pragma unroll
    for (int vt = 0; vt < 8; ++vt) acc[vt] = (f32x4){0.f, 0.f, 0.f, 0.f};
#pragma unroll
    for (int ss = 0; ss < 4; ++ss) { const bf16x8 a = *(const bf16x8*)(kT + (16 * w + r) * 136 + 32 * ss + quad * 8);
#pragma unroll
        for (int vt = 0; vt < 8; ++vt) { const bf16x8 bb = *(const bf16x8*)(vT + (16 * vt + r) * 136 + 32 * ss + quad * 8); acc[vt] = __builtin_amdgcn_mfma_f32_16x16x32_bf16(a, bb, acc[vt], 0, 0, 0); } }
#pragma unroll
    for (int vt = 0; vt < 8; ++vt) { u32x2 o; o.x = cvtpk(acc[vt][0], acc[vt][1]); o.y = cvtpk(acc[vt][2], acc[vt][3]);
        *(u32x2*)(UT + (size_t)unit * 16384 + (16 * vt + r) * 128 + 16 * w + quad * 4) = o; }
    __syncthreads();
}

__device__ __forceinline__ void attn_unit(int au, const bf16_t* PROJ, const float* sbn, bf16_t* MIX, bf16_t* vl) {
    const int lane = threadIdx.x & 63, r32 = lane & 31, hh = lane >> 5;
    const int qt = au & 255, head = (au >> 8) & 7, b = au >> 11;
    const int q0 = 128 + 32 * qt; const size_t mb = (size_t)b * LP;
    const bf16_t* Qp = PROJ + (mb + q0 + r32) * PW + head * 64 + 8 * hh;
    bf16x8 qf[4];
#pragma unroll
    for (int ds = 0; ds < 4; ++ds) qf[ds] = *(const bf16x8*)(Qp + 16 * ds);
    f32x16 o0, o1;
#pragma unroll
    for (int i = 0; i < 16; ++i) { o0[i] = 0.f; o1[i] = 0.f; }
    float carry = 0.f; const int qpos = q0 + r32;
    const int prow = lane >> 3, pcol = (lane & 7) * 8;
    const bf16_t* Kbase = PROJ + (mb + r32) * PW + 512 + head * 64 + 8 * hh;
    const bf16_t* Vbase = PROJ + (mb + prow) * PW + 1024 + head * 64 + pcol;
    int kt = q0 >> 5;
    bf16x8 kn[4]; u32x4 vn[4];
#pragma unroll
    for (int ds = 0; ds < 4; ++ds) kn[ds] = *(const bf16x8*)(Kbase + (size_t)(32 * kt) * PW + 16 * ds);
#pragma unroll
    for (int i = 0; i < 4; ++i) vn[i] = *(const u32x4*)(Vbase + (size_t)(32 * kt + 8 * i) * PW);
    for (;;) {
        const int kv0 = 32 * kt; const bool more = kt > 3;
        bf16x8 kf[4];
#pragma unroll
        for (int ds = 0; ds < 4; ++ds) kf[ds] = kn[ds];
#pragma unroll
        for (int i = 0; i < 4; ++i) *(u32x4*)(vl + (prow + 8 * i) * 72 + pcol) = vn[i];
        asm volatile("" ::: "memory");
        if (more) {
#pragma unroll
            for (int ds = 0; ds < 4; ++ds) kn[ds] = *(const bf16x8*)(Kbase + (size_t)(kv0 - 32) * PW + 16 * ds);
#pragma unroll
            for (int i = 0; i < 4; ++i) vn[i] = *(const u32x4*)(Vbase + (size_t)(kv0 - 32 + 8 * i) * PW);
        }
        f32x16 x;
#pragma unroll
        for (int i = 0; i < 16; ++i) x[i] = 0.f;
#pragma unroll
        for (int ds = 0; ds < 4; ++ds) x = __builtin_amdgcn_mfma_f32_32x32x16_bf16(kf[ds], qf[ds], x, 0, 0, 0);
        float be[16], om[16];
        const bool edge = (kt == (q0 >> 5)) || (kt == 3);
#pragma unroll
        for (int i = 0; i < 16; ++i) { const float zp = x[i]; const float u = __builtin_amdgcn_exp2f(-fabsf(zp)); const float s = __builtin_amdgcn_rcpf(1.0f + u), us = u * s;
            be[i] = zp > 0.f ? s : us; om[i] = zp > 0.f ? us : s; }
        if (edge) {
#pragma unroll
            for (int i = 0; i < 16; ++i) { const int kv = kv0 + (i & 3) + 8 * (i >> 2) + 4 * hh; const bool vis = (kv < qpos) && (kv >= 112); be[i] = vis ? be[i] : 0.f; om[i] = vis ? om[i] : 1.0f; } }
        float gp[4], pp[4], T[4]; float run = 1.0f;
#pragma unroll
        for (int g = 0; g < 4; ++g) gp[g] = (om[4 * g] * om[4 * g + 1]) * (om[4 * g + 2] * om[4 * g + 3]);
#pragma unroll
        for (int g = 0; g < 4; ++g) pp[g] = __shfl_xor(gp[g], 32);
#pragma unroll
        for (int g = 3; g >= 0; --g) { T[g] = hh == 0 ? run * pp[g] : run; run *= gp[g] * pp[g]; }
        const float C = __builtin_amdgcn_exp2f(carry);
        float wv[16];
#pragma unroll
        for (int g = 0; g < 4; ++g) { float a = C * T[g];
#pragma unroll
            for (int e = 3; e >= 0; --e) { const int i = 4 * g + e; wv[i] = be[i] * a; a *= om[i]; } }
        carry += __builtin_amdgcn_logf(run);
        bf16x8 xs[2];
#pragma unroll
        for (int s = 0; s < 2; ++s) { u32x4 pw; pw.x = cvtpk(wv[8 * s], wv[8 * s + 1]); pw.y = cvtpk(wv[8 * s + 2], wv[8 * s + 3]); pw.z = cvtpk(wv[8 * s + 4], wv[8 * s + 5]); pw.w = cvtpk(wv[8 * s + 6], wv[8 * s + 7]);
            xs[s] = __builtin_bit_cast(bf16x8, pw); }
        const bf16_t* vp = vl + (4 * hh) * 72 + r32;
#pragma unroll
        for (int s = 0; s < 2; ++s) {
            bf16x8 va, vb;
#pragma unroll
            for (int j = 0; j < 8; ++j) { const bf16_t* p = vp + (16 * s + 8 * (j >> 2) + (j & 3)) * 72; va[j] = (short)p[0]; vb[j] = (short)p[32]; }
            o0 = __builtin_amdgcn_mfma_f32_32x32x16_bf16(va, xs[s], o0, 0, 0, 0);
            o1 = __builtin_amdgcn_mfma_f32_32x32x16_bf16(vb, xs[s], o1, 0, 0, 0);
        }
        asm volatile("" ::: "memory");
        if (!more || __all(carry < -152.0f)) break;
        --kt;
    }
    float ss = 0.f;
#pragma unroll
    for (int i = 0; i < 16; ++i) ss += o0[i] * o0[i] + o1[i] * o1[i];
    ss += __shfl_xor(ss, 32);
    const float rstd = 1.0f / sqrtf(ss * (1.0f / 64.0f) + EPS);
    bf16_t* orow = MIX + ((size_t)b * SEQ + q0 - 128 + r32) * D + head * 64;
#pragma unroll
    for (int g = 0; g < 4; ++g) { const int d0 = 8 * g + 4 * hh;
        const f32x4 g0 = *(const f32x4*)(sbn + head * 64 + d0), g1 = *(const f32x4*)(sbn + head * 64 + 32 + d0);
        u32x2 w0, w1;
        w0.x = cvtpk(o0[4 * g] * rstd * g0[0], o0[4 * g + 1] * rstd * g0[1]); w0.y = cvtpk(o0[4 * g + 2] * rstd * g0[2], o0[4 * g + 3] * rstd * g0[3]);
        w1.x = cvtpk(o1[4 * g] * rstd * g1[0], o1[4 * g + 1] * rstd * g1[1]); w1.y = cvtpk(o1[4 * g + 2] * rstd * g1[2], o1[4 * g + 3] * rstd * g1[3]);
        *(u32x2*)(orow + d0) = w0; *(u32x2*)(orow + 32 + d0) = w1; }
}

__device__ __forceinline__ void hg_out_stage(int bh, int c, const bf16_t* PROJ, const bf16_t* UT, unsigned char* lds) {
    const int tid = threadIdx.x; const int b = bh >> 2, h = bh & 3, unit = bh * 65 + c;
    const size_t m0 = (size_t)b * LP + (size_t)c * 128;
    stage_vT(PROJ, m0, h, (bf16_t*)lds);
    bf16_t* sT = (bf16_t*)(lds + 34816);
#pragma unroll
    for (int ii = 0; ii < 4; ++ii) { const int p = tid + 512 * ii, s = p >> 4, vc = p & 15;
        const u32x4 e = *(const u32x4*)(UT + (size_t)unit * 16384 + s * 128 + vc * 8); *(u32x4*)(sT + s * 136 + vc * 8) = e; }
}
__device__ __forceinline__ void hg_out_wave(int bh, int c, int i, const bf16_t* KH, const bf16_t* QT, const bf16_t* QB, const float* DB, const bf16_t* PROJ, const float* hgn, bf16_t* MIX, const unsigned char* lds) {
    const int lane = threadIdx.x & 63, r = lane & 15, quad = lane >> 4;
    const int b = bh >> 2, h = bh & 3, unit = bh * 65 + c;
    const size_t m0 = (size_t)b * LP + (size_t)c * 128;
    const bf16_t* vT = (const bf16_t*)lds; const bf16_t* sT = (const bf16_t*)(lds + 34816);
    const size_t mt = m0 + 16 * i + r; const int kc = h * 128 + quad * 8;
    const bf16_t* KHl = KH + (m0 + r) * 512 + kc;
    const float* DBl = DB + (size_t)unit * 1024 + quad * 8;
    bf16x8 qtl[4], qbr[4]; float g[4][8]; u32x4 khn[4]; f32x4 dn[4][2];
#pragma unroll
    for (int ks = 0; ks < 4; ++ks) { qtl[ks] = *(const bf16x8*)(QT + mt * 512 + kc + 32 * ks); qbr[ks] = *(const bf16x8*)(QB + mt * 512 + kc + 32 * ks);
        khn[ks] = *(const u32x4*)(KHl + (size_t)(16 * i) * 512 + 32 * ks);
        const float* dp = DBl + i * 128 + 32 * ks; dn[ks][0] = *(const f32x4*)dp; dn[ks][1] = *(const f32x4*)(dp + 4); }
    f32x4 o[8];
#pragma unroll
    for (int vt = 0; vt < 8; ++vt) o[vt] = (f32x4){0.f, 0.f, 0.f, 0.f};
    f32x4 scA = (f32x4){0.f, 0.f, 0.f, 0.f}, scB = scA; int jA = i;
    for (int jb = i; jb >= 0; --jb) {
        const int mode = (jb == i) ? 0 : ((jb == i - 1) ? 1 : 2);
        u32x4 kh[4];
#pragma unroll
        for (int ks = 0; ks < 4; ++ks) { kh[ks] = khn[ks];
            if (mode == 0) {
#pragma unroll
                for (int j = 0; j < 4; ++j) { g[ks][j] = __builtin_amdgcn_rcpf(fmaxf(dn[ks][0][j], 1e-30f)); g[ks][4 + j] = __builtin_amdgcn_rcpf(fmaxf(dn[ks][1][j], 1e-30f)); } }
            else if (mode == 2) {
#pragma unroll
                for (int j = 0; j < 4; ++j) { g[ks][j] *= dn[ks][0][j]; g[ks][4 + j] *= dn[ks][1][j]; } } }
        if (jb > 0) {
#pragma unroll
            for (int ks = 0; ks < 4; ++ks) { khn[ks] = *(const u32x4*)(KHl + (size_t)(16 * (jb - 1)) * 512 + 32 * ks);
                const float* dp = DBl + jb * 128 + 32 * ks; dn[ks][0] = *(const f32x4*)dp; dn[ks][1] = *(const f32x4*)(dp + 4); } }
        f32x4 sc = (f32x4){0.f, 0.f, 0.f, 0.f};
#pragma unroll
        for (int ks = 0; ks < 4; ++ks) { u32x4 t = kh[ks];
            if (mode != 1) {
#pragma unroll
                for (int j = 0; j < 4; ++j) t[j] = cvtpk(bflo(kh[ks][j]) * g[ks][2 * j], bfhi(kh[ks][j]) * g[ks][2 * j + 1]); }
            sc = __builtin_amdgcn_mfma_f32_16x16x32_bf16(__builtin_bit_cast(bf16x8, t), qtl[ks], sc, 0, 0, 0); }
        if (mode == 0) {
#pragma unroll
            for (int jj = 0; jj < 4; ++jj) if (quad * 4 + jj > r) sc[jj] = 0.f;
#pragma unroll
            for (int ks = 0; ks < 4; ++ks)
#pragma unroll
                for (int j = 0; j < 8; ++j) g[ks][j] = 1.0f; }
        const bool second = ((i - jb) & 1) != 0;
        if (!second) { scA = sc; jA = jb; scB = (f32x4){0.f, 0.f, 0.f, 0.f}; } else scB = sc;
        if (second || jb == 0) {
            u32x4 pp; pp.x = cvtpk(scA[0], scA[1]); pp.y = cvtpk(scA[2], scA[3]); pp.z = cvtpk(scB[0], scB[1]); pp.w = cvtpk(scB[2], scB[3]);
            const bf16x8 pf = __builtin_bit_cast(bf16x8, pp);
            const int cA = 16 * jA + quad * 4, cB = 16 * jb + quad * 4;
#pragma unroll
            for (int vt = 0; vt < 8; ++vt) { const bf16_t* vp = vT + (16 * vt + r) * 136;
                const u32x2 a0 = *(const u32x2*)(vp + cA), a1 = *(const u32x2*)(vp + cB); u32x4 av; av.x = a0.x; av.y = a0.y; av.z = a1.x; av.w = a1.y;
                o[vt] = __builtin_amdgcn_mfma_f32_16x16x32_bf16(__builtin_bit_cast(bf16x8, av), pf, o[vt], 0, 0, 0); }
        }
    }
#pragma unroll
    for (int ks = 0; ks < 4; ++ks)
#pragma unroll
        for (int vt = 0; vt < 8; ++vt) { const bf16x8 sf = *(const bf16x8*)(sT + (16 * vt + r) * 136 + 32 * ks + quad * 8); o[vt] = __builtin_amdgcn_mfma_f32_16x16x32_bf16(sf, qbr[ks], o[vt], 0, 0, 0); }
    float ss = 0.f;
#pragma unroll
    for (int vt = 0; vt < 8; ++vt) ss += (o[vt][0] * o[vt][0] + o[vt][1] * o[vt][1]) + (o[vt][2] * o[vt][2] + o[vt][3] * o[vt][3]);
    ss += __shfl_xor(ss, 16); ss += __shfl_xor(ss, 32);
    const float rstd = __builtin_amdgcn_rsqf(ss * (1.0f / 128.0f) + EPS);
    const bf16_t* gp = PROJ + mt * PW + 2560 + h * 128 + quad * 4;
    bf16_t* op = MIX + ((size_t)b * SEQ + (size_t)c * 128 - 128 + 16 * i + r) * D + 512 + h * 128 + quad * 4;
#pragma unroll
    for (int vt = 0; vt < 8; ++vt) { const u32x2 gw = *(const u32x2*)(gp + 16 * vt); const f32x4 gn = *(const f32x4*)(hgn + h * 128 + 16 * vt + quad * 4);
        const float g0 = bflo(gw.x), g1 = bfhi(gw.x), g2 = bflo(gw.y), g3 = bfhi(gw.y);
        u32x2 ow; ow.x = cvtpk(o[vt][0] * rstd * gn[0] * (g0 * __builtin_amdgcn_rcpf(1.0f + __expf(-g0))), o[vt][1] * rstd * gn[1] * (g1 * __builtin_amdgcn_rcpf(1.0f + __expf(-g1))));
        ow.y = cvtpk(o[vt][2] * rstd * gn[2] * (g2 * __builtin_amdgcn_rcpf(1.0f + __expf(-g2))), o[vt][3] * rstd * gn[3] * (g3 * __builtin_amdgcn_rcpf(1.0f + __expf(-g3))));
        *(u32x2*)(op + 16 * vt) = ow; }
}

#define LAS __attribute__((address_space(3)))
#define XB_TMO      128
#define XB_XCNT(j)  (256  + 64 * (j))
#define XB_XSUB(j)  (1280 + 64 * (j))
#define XB_XGEN(j)  (2304 + 64 * (j))
#define XB_TOP      3328
#define XB_TOPGEN   3392
#define XCD_BAR_WORDS 3456
#define XB_SPIN_CAP (1u << 18)

__device__ __forceinline__ unsigned xb_ld(unsigned* p)              { return __hip_atomic_load(p, __ATOMIC_RELAXED, __HIP_MEMORY_SCOPE_AGENT); }
__device__ __forceinline__ unsigned xb_add(unsigned* p, unsigned v) { return __hip_atomic_fetch_add(p, v, __ATOMIC_RELAXED, __HIP_MEMORY_SCOPE_AGENT); }
__device__ __forceinline__ unsigned xb_xcc_id() { return (unsigned)__builtin_amdgcn_s_getreg((3 << 11) | 20) & 0xFu; }
#define XB_SPIN(cond, bar) do { unsigned _sp = 0; while (cond) { __builtin_amdgcn_s_sleep(1); \
    if ((++_sp & 255u) == 0u) { if (xb_ld(&(bar)[XB_TMO])) break; if (_sp > XB_SPIN_CAP) { atomicAdd(&(bar)[XB_TMO], 1u); break; } } } } while (0)

struct XcdBarrier {
    unsigned* bar; unsigned x;
    volatile LAS unsigned* st;
};

__device__ __forceinline__ XcdBarrier xcd_barrier_post(unsigned* bar, volatile LAS unsigned* st) {
    XcdBarrier b; b.bar = bar; b.x = xb_xcc_id(); b.st = st;
    if (threadIdx.x == 0) (void)xb_add(&bar[XB_XCNT(b.x)], 1u);
    return b;
}
__device__ __forceinline__ void xcd_barrier_complete(unsigned* bar, unsigned x, unsigned& nloc, unsigned& nx) {
    const unsigned G = gridDim.x * gridDim.y * gridDim.z;
    unsigned sum, cnt, mine, sp = 0u;
    for (;;) {
        sum = 0u; cnt = 0u; mine = 0u;
#pragma unroll
        for (unsigned j = 0; j < 16; ++j) { const unsigned c = xb_ld(&bar[XB_XCNT(j)]); sum += c; cnt += (c > 0u) ? 1u : 0u; mine = (j == x) ? c : mine; }
        if (sum == G) break;
        __builtin_amdgcn_s_sleep(1);
        if ((++sp & 255u) == 0u) { if (xb_ld(&bar[XB_TMO])) break; if (sp > XB_SPIN_CAP) { atomicAdd(&bar[XB_TMO], 1u); break; } }
    }
    nloc = mine > 0u ? mine : 1u; nx = cnt > 0u ? cnt : 1u;
}

__device__ __forceinline__ void xcd_barrier(const XcdBarrier& b) {
    asm volatile("s_waitcnt vmcnt(0)" ::: "memory");
    __syncthreads();
    if (threadIdx.x == 0) {
        unsigned* bar = b.bar;
        __builtin_amdgcn_s_waitcnt(0);
        unsigned nloc = b.st[0], nx = b.st[1];
        if (nloc == 0u) { xcd_barrier_complete(bar, b.x, nloc, nx); b.st[0] = nloc; b.st[1] = nx; }
        const unsigned old = xb_add(&bar[XB_XSUB(b.x)], 1u);
        const unsigned gen = old / nloc;
        if (old + 1u == (gen + 1u) * nloc) {
            __builtin_amdgcn_fence(__ATOMIC_RELEASE, "agent");
            asm volatile("s_waitcnt vmcnt(0)" ::: "memory");
            const unsigned og = xb_add(&bar[XB_TOP], 1u);
            const unsigned tg = og / nx;
            if (og + 1u == (tg + 1u) * nx) xb_add(&bar[XB_TOPGEN], 1u);
            else XB_SPIN(xb_ld(&bar[XB_TOPGEN]) == tg, bar);
            __builtin_amdgcn_fence(__ATOMIC_ACQUIRE, "agent");
            xb_add(&bar[XB_XGEN(b.x)], 1u);
            asm volatile("s_waitcnt vmcnt(0)" ::: "memory");
        } else {
            XB_SPIN(xb_ld(&bar[XB_XGEN(b.x)]) == gen, bar);
            __builtin_amdgcn_fence(__ATOMIC_ACQUIRE, "agent");
            asm volatile("s_waitcnt vmcnt(0)" ::: "memory");
        }
    }
    __syncthreads();
}

#ifndef REP_HL
#define REP_HL 1
#endif
#ifndef REP_AT
#define REP_AT 1
#endif
#ifndef REP_P2C
#define REP_P2C 1
#endif
#ifndef REP_SYNC
#define REP_SYNC 1
#endif
#ifndef REP_P0
#define REP_P0 1
#endif
#ifndef REP_P3
#define REP_P3 1
#endif
#ifndef REP_P5
#define REP_P5 1
#endif
#ifndef REP_P2B
#define REP_P2B 1
#endif
#ifndef REP_P1
#define REP_P1 1
#endif
#ifndef REP_P4
#define REP_P4 1
#endif
#define GSYNC() do { for (int rs_ = 0; rs_ < REP_SYNC; ++rs_) xcd_barrier(xbar); } while (0)
struct Args { const float* in[13]; float* out; unsigned char* ws; long long pad; };
__global__ void __launch_bounds__(512, 2) hybrid_fwd(Args a) {
    extern __shared__ __attribute__((aligned(16))) unsigned char lds[];
    cg::grid_group grid = cg::this_grid();
    const int tid = threadIdx.x, lane = tid & 63, wave = __builtin_amdgcn_readfirstlane(tid >> 6);
    const int G = gridDim.x, bx = blockIdx.x;
    typedef const __attribute__((address_space(4))) unsigned char* kptr_t;
    kptr_t kp = (kptr_t)__builtin_amdgcn_kernarg_segment_ptr();
#define KIN(i) (*(const float* const __attribute__((address_space(4)))*)(kp + 8 * (i)))
#define PH_BEGIN() asm volatile("" : "+s"(kp)); unsigned char* const ws = *(unsigned char* const __attribute__((address_space(4)))*)(kp + 112)
#define W_BF(off) ((bf16_t*)(ws + (off)))
#define W_F32(off) ((float*)(ws + (off)))
    volatile LAS unsigned* bst = (volatile LAS unsigned*)((LAS unsigned char*)lds + LDS_BYTES - 64);
    if (tid == 0) { bst[0] = 0u; bst[1] = 0u; }
    __syncthreads();
    const XcdBarrier xbar = xcd_barrier_post((unsigned*)a.ws, bst);
    PG8_LAS unsigned char* ldsp = (PG8_LAS unsigned char*)lds;

    {
        PH_BEGIN(); const float *x = KIN(0), *meta = KIN(1), *n1g = KIN(2), *w_in = KIN(3), *w_out = KIN(7), *n2g = KIN(8), *w_gate = KIN(9), *w_up = KIN(10), *w_down = KIN(11);
        bf16_t *Win_t = W_BF(WS_WIN), *Wout_t = W_BF(WS_WOUT), *Wgu_t = W_BF(WS_WGU), *Wdn_t = W_BF(WS_WDN), *U = W_BF(WS_U);
        float* scr = (float*)(lds + wave * 16384);
        const int gw = bx * 8 + wave, NGW = G * 8;
        constexpr int I_IN = (D / 64) * (INW / 32), I_OUT = (D / 64) * (D / 32), I_G = (D / 64) * (FF / 32), I_DN = (FF / 64) * (D / 32);
        constexpr int NITEMS = I_IN + I_OUT + 2 * I_G + I_DN;
        for (int it = gw; it < NITEMS * REP_P0; it += NGW) {
            int r = it % NITEMS;
            if (r < I_IN) { p0_transpose_item<0>(w_in, D, INW, Win_t, nullptr, scr, r, lane); continue; } r -= I_IN;
            if (r < I_OUT) { p0_transpose_item<0>(w_out, D, D, Wout_t, nullptr, scr, r, lane); continue; } r -= I_OUT;
            if (r < I_G) { p0_transpose_item<1>(w_gate, D, FF, Wgu_t, n2g, scr, r, lane); continue; } r -= I_G;
            if (r < I_G) { p0_transpose_item<2>(w_up, D, FF, Wgu_t, n2g, scr, r, lane); continue; } r -= I_G;
            p0_transpose_item<0>(w_down, FF, D, Wdn_t, nullptr, scr, r, lane);
        }
        for (int mm = gw * 4; mm < MP * REP_P0; mm += NGW * 4) u_rows4(mm % MP, x, meta, n1g, U, lane);
    }
    if (a.pad != 0) grid.sync();
    GSYNC();
    {
        PH_BEGIN(); const float* lbl = KIN(6); bf16_t *U = W_BF(WS_U), *Win_t = W_BF(WS_WIN), *PROJ = W_BF(WS_PROJ); float* LOGF = W_F32(WS_LOGF);
        pg8::Gemm g{U, Win_t, MP, INW, D}; pg8::StaticOrder S; S.init(MP, INW, G, bx); S.rep = REP_P1;
        pg8::EpiProj E{PROJ, LOGF, lbl};
        pg8::gemm_phase<pg8::EpiProj, pg8::StaticOrder, true, true>(ldsp, g, S, E);
    }
    GSYNC();
    {
        PH_BEGIN(); const float* sbn = KIN(4); bf16_t *PROJ = W_BF(WS_PROJ), *UT = W_BF(WS_UT), *MIX = W_BF(WS_MIX); float *LOGF = W_F32(WS_LOGF), *DB = W_F32(WS_U), *DEC = W_F32(WS_SMALL);
        bf16_t* KH = *(bf16_t* const __attribute__((address_space(4)))*)(kp + 104); bf16_t *QT = KH + (size_t)MP * 512, *QB = KH + (size_t)MP * 1024;
        for (int uu = bx; uu < 512 * REP_HL; uu += G) hg_local_unit(((uu >> 6) & 7) * 65 + (uu & 63), false, LOGF, PROJ, KH, QT, QB, DB, UT, DEC, lds);
        for (int uu = bx; uu < 8; uu += G) hg_local_unit(uu * 65 + 64, true, LOGF, PROJ, KH, QT, QB, DB, UT, DEC, lds);
        for (int au = bx * 8 + wave; au < 4096 * REP_AT; au += G * 8) attn_unit(au & 4095, PROJ, sbn, MIX, (bf16_t*)(lds + 73728 + wave * 4608));
    }
    GSYNC();
    {
        PH_BEGIN(); const bf16_t* __restrict__ UT = W_BF(WS_UT); bf16_t* __restrict__ SP = W_BF(WS_SPREV); const float* __restrict__ DEC = W_F32(WS_SMALL);
        for (int rb = 0; rb < REP_P2B; ++rb) {
        const int gid = bx * 512 + tid;
        if (gid < 65536) { const int bh = gid >> 13, e2 = gid & 8191, k2 = (2 * e2) & 127;
            float s0 = 0.f, s1 = 0.f;
            for (int c0 = 0; c0 < 64; c0 += 32) {
                unsigned uu[32]; float d0[32], d1[32];
#pragma unroll
                for (int j = 0; j < 32; ++j) { const int unit = bh * 65 + c0 + j; uu[j] = *((const unsigned*)(UT + (size_t)unit * 16384) + e2);
                    const float2 dd = *(const float2*)(DEC + unit * 128 + k2); d0[j] = dd.x; d1[j] = dd.y; }
#pragma unroll
                for (int j = 0; j < 32; ++j) { const int unit = bh * 65 + c0 + j; *((unsigned*)(SP + (size_t)unit * 16384) + e2) = cvtpk(s0, s1);
                    s0 = d0[j] * s0 + bflo(uu[j]); s1 = d1[j] * s1 + bfhi(uu[j]); }
            }
            *((unsigned*)(SP + (size_t)(bh * 65 + 64) * 16384) + e2) = cvtpk(s0, s1);
        }
        }
    }
    GSYNC();
    {
        PH_BEGIN(); const float* hgn = KIN(5); bf16_t *PROJ = W_BF(WS_PROJ), *UT = W_BF(WS_SPREV), *MIX = W_BF(WS_MIX); const float* DB = W_F32(WS_U);
        const bf16_t* KH = *(bf16_t* const __attribute__((address_space(4)))*)(kp + 104); const bf16_t *QT = KH + (size_t)MP * 512, *QB = KH + (size_t)MP * 1024;
        for (int rr = 0; rr < REP_P2C; ++rr) {
            const int bhA = bx >> 6, bhB = 4 + (bx >> 6), cc = (bx & 63) + 1;
            hg_out_stage(bhA, cc, PROJ, UT, lds); hg_out_stage(bhB, cc, PROJ, UT, lds + 69632);
            __syncthreads();
            hg_out_wave(bhA, cc, wave, KH, QT, QB, DB, PROJ, hgn, MIX, lds);
            hg_out_wave(bhB, cc, 7 - wave, KH, QT, QB, DB, PROJ, hgn, MIX, lds + 69632);
            __syncthreads();
        }
    }
    GSYNC();
    {
        PH_BEGIN(); const float* x = KIN(0); float* out = *(float* const __attribute__((address_space(4)))*)(kp + 104); bf16_t *MIX = W_BF(WS_MIX), *Wout_t = W_BF(WS_WOUT), *H2B = W_BF(WS_LOGF); float* SS2 = W_F32(WS_SMALL + 512 * 1024);
        pg8::Gemm g{MIX, Wout_t, MX, D, D}; pg8::StaticOrder S; S.init(MX, D, G, bx); S.rep = REP_P3;
        pg8::EpiResid E{x, nullptr, H2B, SS2};
        pg8::gemm_phase<pg8::EpiResid, pg8::StaticOrder, false, true>(ldsp, g, S, E);
    }
    GSYNC();
    {
        PH_BEGIN(); bf16_t *H2B = W_BF(WS_LOGF), *Wgu_t = W_BF(WS_WGU), *HID = W_BF(WS_PROJ); float* SS2 = W_F32(WS_SMALL + 512 * 1024);
        pg8::Gemm g{H2B, Wgu_t, MX, 2 * FF, D}; pg8::StaticOrder S; S.init(MX, 2 * FF, G, bx); S.rep = REP_P4;
        pg8::EpiSwiglu E{HID, SS2};
        pg8::gemm_phase<pg8::EpiSwiglu, pg8::StaticOrder, true, true>(ldsp, g, S, E);
    }
    GSYNC();
    {
        PH_BEGIN(); const float* fng = KIN(12); float* out = *(float* const __attribute__((address_space(4)))*)(kp + 104); bf16_t *HID = W_BF(WS_PROJ), *Wdn_t = W_BF(WS_WDN); float* SS3 = W_F32(WS_SMALL + 768 * 1024);
        pg8::Gemm g{HID, Wdn_t, MX, D, FF}; pg8::StaticOrder S; S.init(MX, D, G, bx); S.rep = REP_P5;
        pg8::EpiFinal E{W_BF(WS_LOGF), out, SS3, (unsigned*)(ws + 16384), fng};
        pg8::gemm_phase<pg8::EpiFinal, pg8::StaticOrder, false, true>(ldsp, g, S, E);
    }
}

extern "C" void kernel_launch(void* const* d_in, const int* in_sizes, int n_in, void* d_out, int out_size, void* d_ws, size_t ws_size, hipStream_t stream) {
    static int ready = 0;
    if (!ready) {
        if (n_in != 13 || out_size != MX * D || ws_size < 242 * MiB) { fprintf(stderr, "kernel_launch: unexpected problem shape (n_in %d, out %d, ws %zu)\n", n_in, out_size, ws_size); ready = -1; return; }
        if (hipFuncSetAttribute((const void*)hybrid_fwd, hipFuncAttributeMaxDynamicSharedMemorySize, LDS_BYTES) != hipSuccess) { fprintf(stderr, "kernel_launch: hipFuncSetAttribute failed\n"); ready = -1; return; }
        ready = 1;
    }
    if (ready < 0) return;
    Args a{};
    for (int i = 0; i < 13; ++i) a.in[i] = (const float*)d_in[i];
    a.out = (float*)d_out; a.ws = (unsigned char*)d_ws; a.pad = 0;
    if (hipMemsetAsync(d_ws, 0, 32768, stream) != hipSuccess) { fprintf(stderr, "kernel_launch: memset failed\n"); return; }
    void* args[] = {&a};
    const hipError_t e = hipLaunchCooperativeKernel((const void*)hybrid_fwd, dim3(NWG), dim3(512), args, LDS_BYTES, stream);
    if (e != hipSuccess) fprintf(stderr, "kernel_launch: cooperative launch failed: %s\n", hipGetErrorString(e));
}
```

```cpp
#include <hip/hip_runtime.h>
#include <hip/hip_cooperative_groups.h>
#include <cstdio>
#include <cstdint>
namespace cg = cooperative_groups;
namespace pg8 {
#define PG8_LAS __attribute__((address_space(3)))
typedef unsigned short bf16_t;
typedef short bf16x8 __attribute__((ext_vector_type(8)));
typedef float f32x4 __attribute__((ext_vector_type(4)));
typedef unsigned u32x4 __attribute__((ext_vector_type(4)));
constexpr int BM = 256, BK = 64, HALF = 128, HTB = HALF * BK * 2  , STAGE_BYTES = 8 * HTB, NXCD = 8, WGM = 8;

__host__ __device__ __forceinline__ int lds_byte(int r, int c) { const int st = (r >> 4) * 2 + (c >> 5), rr = r & 15, cc = c & 31, ob = rr * 64 + cc * 2; return st * 1024 + (ob ^ (((ob >> 9) & 1) << 5)); }
__host__ __device__ __forceinline__ void stage_rc(int b, int& R, int& C) { const int st = b / 1024, sb = b % 1024, swz = sb ^ (((sb >> 9) & 1) << 5); R = (st >> 1) * 16 + swz / 64; C = (st & 1) * 32 + (swz % 64) / 2; }
__host__ __device__ __forceinline__ int perm32(int rho) { const int n = rho >> 4, i = rho & 15; return 8 * (i >> 2) + 4 * n + (i & 3); }

struct Unit { int pm, pn; };
struct Gemm { const bf16_t* A; const bf16_t* Bt; int M, N, K; };

struct StaticOrder {
    int nM, nN, nwg, G, c, rep;
    __host__ __device__ void init(int M, int N, int G_, int c_) { nM = M / BM; nN = N / BM; nwg = nM * nN; G = G_; c = c_; rep = 1; }
    __host__ __device__ bool next(int i, Unit& u) const {
        const long L = (long)i * G + c; if (L >= (long)nwg * rep) return false;
        int wgid = (int)(L % nwg); { const int q = nwg / NXCD, r = nwg % NXCD, xcd = wgid % NXCD, off = wgid / NXCD; wgid = (xcd < r ? xcd * (q + 1) : r * (q + 1) + (xcd - r) * q) + off; }
        const int nig = WGM * nN, gid = wgid / nig, fm = gid * WGM, gsz = (nM - fm) < WGM ? (nM - fm) : WGM;
        u.pm = fm + ((wgid % nig) % gsz); u.pn = (wgid % nig) / gsz; return true;
    }
    __device__ __forceinline__ void a_ready(const Unit&) const {}
    __device__ __forceinline__ void done(const Unit&) const {}
};

__device__ __forceinline__ unsigned cvt_pk_bf16(float lo, float hi) { unsigned r; asm volatile("v_cvt_pk_bf16_f32 %0, %1, %2" : "=v"(r) : "v"(lo), "v"(hi)); return r; }
typedef float f32x2 __attribute__((ext_vector_type(2)));
typedef float f32x2_t __attribute__((ext_vector_type(2))); typedef __bf16 bf16x2_t __attribute__((ext_vector_type(2)));
__device__ __forceinline__ unsigned cvtpk(float lo, float hi) { f32x2_t v = {lo, hi}; bf16x2_t b = __builtin_convertvector(v, bf16x2_t); return __builtin_bit_cast(unsigned, b); }
typedef unsigned u32x2 __attribute__((ext_vector_type(2)));
#ifndef WT_STORES
#define WT_STORES 1
#endif
__device__ __forceinline__ void st16(void* p, u32x4 v) {
#if WT_STORES
    asm volatile("global_store_dwordx4 %0, %1, off sc1\n\ts_nop 1" :: "v"(p), "v"(v) : "memory");
#else
    *(u32x4*)p = v;
#endif
}

struct EpiProj {
    static constexpr bool PERM = true, AFTER_DRAIN = false;
    bf16_t* proj; float* logf; const float* lbl;
    __device__ __forceinline__ void operator()(const f32x4 (&acc)[2][2][4][2], const Unit& u, int wr, int wc, int fr, int fq) const {
        const int row0 = u.pm * BM + wr * 64 + fr, colt = u.pn * BM, seg = colt >> 9;
        if (seg != 4) {
            const float sc = (seg == 0) ? 0.18033688011112042f : 1.f;
            const int pc = (colt < 2048 ? colt : colt - 512) + wc * 32 + 8 * fq;
#pragma unroll
            for (int ai = 0; ai < 2; ++ai)
#pragma unroll
                for (int m = 0; m < 4; ++m) { bf16_t* rowp = proj + (size_t)(row0 + ai * HALF + m * 16) * 3072 + pc;
#pragma unroll
                    for (int bj = 0; bj < 2; ++bj) { const f32x4 v0 = acc[ai][bj][m][0] * sc, v1 = acc[ai][bj][m][1] * sc;
                        u32x4 w; w.x = cvtpk(v0[0], v0[1]); w.y = cvtpk(v0[2], v0[3]); w.z = cvtpk(v1[0], v1[1]); w.w = cvtpk(v1[2], v1[3]);
                        st16(rowp + bj * HALF, w); } }
        } else {
            const int c0 = colt - 2048 + wc * 32 + 8 * fq;
            float oml[2][8];
#pragma unroll
            for (int bj = 0; bj < 2; ++bj)
#pragma unroll
                for (int e = 0; e < 8; ++e) { const int c = c0 + bj * HALF + e; oml[bj][e] = 1.0f / (1.0f + __expf(lbl[c] - lbl[512 + c])); }
#pragma unroll
            for (int ai = 0; ai < 2; ++ai)
#pragma unroll
                for (int m = 0; m < 4; ++m) { const int row = row0 + ai * HALF + m * 16; const bool valid = (row % 8320) >= 112; float* rowp = logf + (size_t)row * 512 + c0;
#pragma unroll
                    for (int bj = 0; bj < 2; ++bj)
#pragma unroll
                        for (int n = 0; n < 2; ++n) { f32x4 o;
#pragma unroll
                            for (int e = 0; e < 4; ++e) { const float f = acc[ai][bj][m][n][e]; const float k = oml[bj][4 * n + e] * __builtin_amdgcn_rcpf(1.0f + __expf(f)); o[e] = valid ? __logf(1.0f - k) : 0.f; }
                            *(f32x4*)(rowp + bj * HALF + 4 * n) = o; } }
        }
    }
};

struct EpiResid {
    static constexpr bool PERM = false, AFTER_DRAIN = true;
    const float* base; float* out; bf16_t* outb; float* ss;
    __device__ __forceinline__ void fused(f32x4 (&acc)[2][2][4][2], const Unit& u, int wr, int wc, int fr, int fq, PG8_LAS unsigned char* lds, int wid, int lane) const {
        PG8_LAS float* P = (PG8_LAS float*)lds;
        const int col0 = u.pn * BM + wc * 32 + 4 * fq;
#pragma unroll
        for (int ai = 0; ai < 2; ++ai) {
            f32x4 pre[4][2][2];
#pragma unroll
            for (int m = 0; m < 4; ++m) { const size_t off = (size_t)(u.pm * BM + ai * HALF + wr * 64 + m * 16 + fr) * 1024 + col0;
#pragma unroll
                for (int bj = 0; bj < 2; ++bj)
#pragma unroll
                    for (int n = 0; n < 2; ++n) pre[m][bj][n] = *(const f32x4*)(base + off + bj * HALF + n * 16); }
            asm volatile("" ::: "memory");
#pragma unroll
            for (int m = 0; m < 4; ++m) { const int r = ai * HALF + wr * 64 + m * 16 + fr; const size_t off = (size_t)(u.pm * BM + r) * 1024 + col0; float s = 0.f;
#pragma unroll
                for (int bj = 0; bj < 2; ++bj)
#pragma unroll
                    for (int n = 0; n < 2; ++n) { const f32x4 o = pre[m][bj][n] + acc[ai][bj][m][n];
                        if (out) *(f32x4*)(out + off + bj * HALF + n * 16) = o;
                        s += (o[0] * o[0] + o[1] * o[1]) + (o[2] * o[2] + o[3] * o[3]);
                        if (outb) { u32x2 w; w.x = cvtpk(o[0], o[1]); w.y = cvtpk(o[2], o[3]); *(u32x2*)(outb + off + bj * HALF + n * 16) = w; } }
                s += __shfl_xor(s, 16); s += __shfl_xor(s, 32);
                if (fq == 0) P[r * 4 + wc] = s; }
            asm volatile("" ::: "memory");
        }
        __syncthreads();
        const int tid = wid * 64 + lane;
        if (tid < 256) { const float t = (P[tid * 4 + 0] + P[tid * 4 + 1]) + (P[tid * 4 + 2] + P[tid * 4 + 3]); ss[(size_t)(u.pm * BM + tid) * 4 + u.pn] = t; }
    }
};

struct EpiSwiglu {
    static constexpr bool PERM = true, AFTER_DRAIN = false;
    bf16_t* hid; const float* ss;
    __device__ __forceinline__ void operator()(const f32x4 (&acc)[2][2][4][2], const Unit& u, int wr, int wc, int fr, int fq) const {
        const int row0 = u.pm * BM + wr * 64 + fr, col0 = u.pn * HALF + wc * 32 + 8 * fq;
#pragma unroll
        for (int ai = 0; ai < 2; ++ai)
#pragma unroll
            for (int m = 0; m < 4; ++m) { const int row = row0 + ai * HALF + m * 16; const f32x4 s4 = *(const f32x4*)(ss + (size_t)row * 4);
                const float rstd = __builtin_amdgcn_rsqf(((s4[0] + s4[1]) + (s4[2] + s4[3])) * (1.0f / 1024.0f) + 1e-6f);
                float a[8];
#pragma unroll
                for (int n = 0; n < 2; ++n)
#pragma unroll
                    for (int e = 0; e < 4; ++e) { const float g = acc[ai][0][m][n][e] * rstd, up = acc[ai][1][m][n][e] * rstd; a[4 * n + e] = g * __builtin_amdgcn_rcpf(1.0f + __expf(-g)) * up; }
                u32x4 w; w.x = cvtpk(a[0], a[1]); w.y = cvtpk(a[2], a[3]); w.z = cvtpk(a[4], a[5]); w.w = cvtpk(a[6], a[7]);
                st16(hid + (size_t)row * 2816 + col0, w); }
    }
};

struct EpiFinal {
    static constexpr bool PERM = false, AFTER_DRAIN = true;
    const bf16_t* base; float* out; float* ss; unsigned* cnt; const float* gf;
    __device__ __forceinline__ void fused(f32x4 (&acc)[2][2][4][2], const Unit& u, int wr, int wc, int fr, int fq, PG8_LAS unsigned char* lds, int wid, int lane) const {
        PG8_LAS float* P = (PG8_LAS float*)lds;
        PG8_LAS float* S = (PG8_LAS float*)(lds + 4096);
        const int col0 = u.pn * BM + wc * 32 + 4 * fq;
        u32x2 pre[2][4][2][2];
#pragma unroll
        for (int ai = 0; ai < 2; ++ai)
#pragma unroll
            for (int m = 0; m < 4; ++m) { const size_t off = (size_t)(u.pm * BM + ai * HALF + wr * 64 + m * 16 + fr) * 1024 + col0;
#pragma unroll
                for (int bj = 0; bj < 2; ++bj)
#pragma unroll
                    for (int n = 0; n < 2; ++n) pre[ai][m][bj][n] = *(const u32x2*)(base + off + bj * HALF + n * 16); }
        asm volatile("" ::: "memory");
#pragma unroll
        for (int ai = 0; ai < 2; ++ai)
#pragma unroll
            for (int m = 0; m < 4; ++m) { const int r = ai * HALF + wr * 64 + m * 16 + fr; float s = 0.f;
#pragma unroll
                for (int bj = 0; bj < 2; ++bj)
#pragma unroll
                    for (int n = 0; n < 2; ++n) { const u32x2 bw = pre[ai][m][bj][n];
                        const f32x4 bs = (f32x4){__uint_as_float(bw.x << 16), __uint_as_float(bw.x & 0xffff0000u), __uint_as_float(bw.y << 16), __uint_as_float(bw.y & 0xffff0000u)}; const f32x4 o = bs + acc[ai][bj][m][n];
                        acc[ai][bj][m][n] = o; s += (o[0] * o[0] + o[1] * o[1]) + (o[2] * o[2] + o[3] * o[3]); }
                s += __shfl_xor(s, 16); s += __shfl_xor(s, 32);
                if (fq == 0) P[r * 4 + wc] = s; }
        __syncthreads();
        const int tid = wid * 64 + lane;
        float* slot = ss + (size_t)(u.pm * BM + (tid & 255)) * 4;
        if (tid < 256) { const float t = (P[tid * 4 + 0] + P[tid * 4 + 1]) + (P[tid * 4 + 2] + P[tid * 4 + 3]); __hip_atomic_store(slot + u.pn, t, __ATOMIC_RELAXED, __HIP_MEMORY_SCOPE_AGENT); }
        asm volatile("s_waitcnt vmcnt(0)" ::: "memory");
        unsigned* c = cnt + 64 * u.pm;
        if (lane == 0) __hip_atomic_fetch_add(c, 1u, __ATOMIC_RELAXED, __HIP_MEMORY_SCOPE_AGENT);
        if (wid == 0) {
            unsigned sp = 0;
            while ((unsigned)__builtin_amdgcn_readfirstlane(__hip_atomic_load(c, __ATOMIC_RELAXED, __HIP_MEMORY_SCOPE_AGENT)) < 32u) { __builtin_amdgcn_s_sleep(2); if (++sp > (1u << 22)) break; }
            __builtin_amdgcn_fence(__ATOMIC_ACQUIRE, "agent");
        }
        asm volatile("s_waitcnt vmcnt(0) lgkmcnt(0)" ::: "memory");
        __syncthreads();
        if (tid < 256) { float t4[4];
#pragma unroll
            for (int t = 0; t < 4; ++t) t4[t] = __hip_atomic_load(slot + t, __ATOMIC_RELAXED, __HIP_MEMORY_SCOPE_AGENT);
            S[tid] = 1.0f / sqrtf(((t4[0] + t4[1]) + (t4[2] + t4[3])) * (1.0f / 1024.0f) + 1e-6f); }
        __syncthreads();
#pragma unroll
        for (int ai = 0; ai < 2; ++ai)
#pragma unroll
            for (int m = 0; m < 4; ++m) { const int r = ai * HALF + wr * 64 + m * 16 + fr; const float rs = S[r]; const size_t off = (size_t)(u.pm * BM + r) * 1024 + col0;
#pragma unroll
                for (int bj = 0; bj < 2; ++bj)
#pragma unroll
                    for (int n = 0; n < 2; ++n) { const f32x4 g4 = *(const f32x4*)(gf + col0 + bj * HALF + n * 16); *(f32x4*)(out + off + bj * HALF + n * 16) = acc[ai][bj][m][n] * rs * g4; } }
    }
};
template <class Epi, class Sched, bool ALIGN_EPI = false, bool SP2 = false>
__device__ __forceinline__ void gemm_phase(PG8_LAS unsigned char* lds, const Gemm g, const Sched& S, const Epi& E) {
    int tid_ = threadIdx.x; asm volatile("" : "+v"(tid_));
    const int tid = tid_, wid = __builtin_amdgcn_readfirstlane(tid >> 6), lane = tid & 63, wr = wid >> 2, wc = wid & 3, fr = lane & 15, fq = lane >> 4;
    const int K = g.K, nt = K / BK;
    unsigned voffA[2], voffB[2];
#pragma unroll
    for (int i = 0; i < 2; ++i) { int R, C; stage_rc(tid * 16 + i * 8192, R, C); const int Rb = Epi::PERM ? ((R & ~31) + perm32(R & 31)) : R;
        voffA[i] = (unsigned)(R * K + C) * 2u; voffB[i] = (unsigned)(Rb * K + C) * 2u; }
    const size_t kstep = (size_t)(BK * 2);
    const size_t hstep = (size_t)HALF * K * 2;
    const size_t tstep = 2 * hstep;
    const unsigned ldsw = (unsigned)wid * 1024u;
    const int aoff = lds_byte(wr * 64 + fr, fq * 8), boff = lds_byte(wc * 32 + fr, fq * 8);
#define PG8_SA(b, h) (((b) * 2 + (h)) * HTB)
#define PG8_SB(b, h) ((4 + (b) * 2 + (h)) * HTB)
#define PG8_STAGE(bufoff, gbase, voff) do { _Pragma("unroll") for (int _i = 0; _i < 2; ++_i) \
        __builtin_amdgcn_global_load_lds((const unsigned*)((const char*)(gbase) + (voff)[_i]), (PG8_LAS unsigned*)(lds + (bufoff) + ldsw + _i * 8192), 16, 0, 0); } while (0)
#define PG8_LDA(dst, b, h) do { _Pragma("unroll") for (int m = 0; m < 4; ++m) _Pragma("unroll") for (int k = 0; k < 2; ++k) dst[m][k] = *(const PG8_LAS bf16x8*)(lds + PG8_SA(b, h) + aoff + m * 2048 + k * 1024); } while (0)
#define PG8_LDB(dst, b, h) do { _Pragma("unroll") for (int n = 0; n < 2; ++n) _Pragma("unroll") for (int k = 0; k < 2; ++k) dst[n][k] = *(const PG8_LAS bf16x8*)(lds + PG8_SB(b, h) + boff + n * 2048 + k * 1024); } while (0)
#define PG8_MMA(ai, bj, At, Bt) do { __builtin_amdgcn_s_setprio(1); _Pragma("unroll") for (int m = 0; m < 4; ++m) _Pragma("unroll") for (int n = 0; n < 2; ++n) _Pragma("unroll") for (int k = 0; k < 2; ++k) \
        acc[ai][bj][m][n] = __builtin_amdgcn_mfma_f32_16x16x32_bf16(Bt[n][k], At[m][k], acc[ai][bj][m][n], 0, 0, 0); __builtin_amdgcn_s_setprio(0); } while (0)
#define PG8_WAIT_V(n) asm volatile("s_waitcnt vmcnt(" #n ")" ::: "memory")
#define PG8_WAIT_L(n) asm volatile("s_waitcnt lgkmcnt(" #n ")" ::: "memory")
#define PG8_BAR __builtin_amdgcn_s_barrier()
#define PG8_SCHED __builtin_amdgcn_sched_barrier(0)
    Unit cur, nxt; int ui = 0;
    if (!S.next(0, cur)) return;
    f32x4 acc[2][2][4][2];
#pragma unroll
    for (int a = 0; a < 2; ++a)
#pragma unroll
        for (int b = 0; b < 2; ++b)
#pragma unroll
            for (int m = 0; m < 4; ++m)
#pragma unroll
                for (int n = 0; n < 2; ++n) acc[a][b][m][n] = (f32x4){0.f, 0.f, 0.f, 0.f};
    bf16x8 At[4][2], B0[2][2], B1[2][2];
    const char* cA = (const char*)g.A + (size_t)cur.pm * tstep; const char* cB = (const char*)g.Bt + (size_t)cur.pn * tstep;
    S.a_ready(cur);
    if constexpr (SP2) {
        PG8_STAGE(PG8_SB(0, 0), cB, voffB); PG8_STAGE(PG8_SB(0, 1), cB + hstep, voffB); PG8_STAGE(PG8_SA(0, 0), cA, voffA); PG8_STAGE(PG8_SA(0, 1), cA + hstep, voffA);
        if (wr == 1) PG8_BAR;
        PG8_WAIT_V(2); PG8_BAR;
        PG8_STAGE(PG8_SB(1, 0), cB + kstep, voffB); PG8_STAGE(PG8_SA(1, 0), cA + kstep, voffA); PG8_STAGE(PG8_SB(1, 1), cB + hstep + kstep, voffB);
        PG8_WAIT_V(6); PG8_BAR;
    } else {
        PG8_STAGE(PG8_SB(0, 0), cB, voffB); PG8_STAGE(PG8_SA(0, 0), cA, voffA); PG8_STAGE(PG8_SB(0, 1), cB + hstep, voffB); PG8_STAGE(PG8_SA(0, 1), cA + hstep, voffA);
        if (wr == 1) PG8_BAR;
        PG8_WAIT_V(4); PG8_BAR;
        PG8_STAGE(PG8_SB(1, 0), cB + kstep, voffB); PG8_STAGE(PG8_SA(1, 0), cA + kstep, voffA); PG8_STAGE(PG8_SB(1, 1), cB + hstep + kstep, voffB);
        PG8_WAIT_V(6); PG8_BAR;
    }
    for (;;) {
        const bool has_next = S.next(ui + 1, nxt);
        const char* nA = has_next ? (const char*)g.A + (size_t)nxt.pm * tstep : cA; const char* nB = has_next ? (const char*)g.Bt + (size_t)nxt.pn * tstep : cB;
        for (int t = 0; t < nt; t += 2) {
            const bool last = (t == nt - 2);
            const char* a1 = cA + (size_t)(t + 1) * kstep;
            const char* a2 = last ? nA : cA + (size_t)(t + 2) * kstep; const char* b2 = last ? nB : cB + (size_t)(t + 2) * kstep;
            const char* a3 = a2 + kstep; const char* b3 = b2 + kstep;
            if (last && has_next) S.a_ready(nxt);
            if constexpr (SP2) {
            PG8_LDB(B0, 0, 0); PG8_LDB(B1, 0, 1); PG8_SCHED; PG8_LDA(At, 0, 0); PG8_STAGE(PG8_SA(1, 1), a1 + hstep, voffA);
            PG8_WAIT_V(8); PG8_WAIT_L(0); PG8_BAR; PG8_MMA(0, 0, At, B0); PG8_MMA(0, 1, At, B1); PG8_BAR; PG8_SCHED;
            PG8_LDA(At, 0, 1); PG8_STAGE(PG8_SB(0, 0), b2, voffB); PG8_STAGE(PG8_SB(0, 1), b2 + hstep, voffB); PG8_STAGE(PG8_SA(0, 0), a2, voffA);
            PG8_WAIT_V(8); PG8_WAIT_L(0); PG8_BAR; PG8_MMA(1, 0, At, B0); PG8_MMA(1, 1, At, B1); PG8_BAR; PG8_SCHED;
            PG8_LDB(B0, 1, 0); PG8_LDB(B1, 1, 1); PG8_SCHED; PG8_LDA(At, 1, 0); PG8_STAGE(PG8_SA(0, 1), a2 + hstep, voffA);
            PG8_WAIT_V(8); PG8_WAIT_L(0); PG8_BAR; PG8_MMA(0, 0, At, B0); PG8_MMA(0, 1, At, B1); PG8_BAR; PG8_SCHED;
            PG8_LDA(At, 1, 1); PG8_STAGE(PG8_SB(1, 0), b3, voffB); PG8_STAGE(PG8_SB(1, 1), b3 + hstep, voffB); PG8_STAGE(PG8_SA(1, 0), a3, voffA);
            PG8_WAIT_V(8); PG8_WAIT_L(0); PG8_BAR; PG8_MMA(1, 0, At, B0); PG8_MMA(1, 1, At, B1); PG8_BAR; PG8_SCHED;
            } else {
            PG8_LDB(B0, 0, 0); PG8_SCHED; PG8_LDA(At, 0, 0); PG8_STAGE(PG8_SA(1, 1), a1 + hstep, voffA);
            PG8_WAIT_L(8); PG8_BAR; PG8_WAIT_L(0); PG8_MMA(0, 0, At, B0); PG8_BAR; PG8_SCHED;
            PG8_LDB(B1, 0, 1); PG8_STAGE(PG8_SB(0, 0), b2, voffB);
            PG8_BAR; PG8_WAIT_L(0); PG8_MMA(0, 1, At, B1); PG8_BAR;
            PG8_LDA(At, 0, 1); PG8_STAGE(PG8_SA(0, 0), a2, voffA);
            PG8_BAR; PG8_WAIT_L(0); PG8_MMA(1, 0, At, B0); PG8_BAR; PG8_SCHED;
            PG8_STAGE(PG8_SB(0, 1), b2 + hstep, voffB);
            PG8_WAIT_V(6); PG8_BAR; PG8_MMA(1, 1, At, B1); PG8_BAR;
            PG8_LDB(B0, 1, 0); PG8_SCHED; PG8_LDA(At, 1, 0); PG8_STAGE(PG8_SA(0, 1), a2 + hstep, voffA);
            PG8_WAIT_L(8); PG8_BAR; PG8_WAIT_L(0); PG8_MMA(0, 0, At, B0); PG8_BAR; PG8_SCHED;
            PG8_LDB(B1, 1, 1); PG8_STAGE(PG8_SB(1, 0), b3, voffB);
            PG8_BAR; PG8_WAIT_L(0); PG8_MMA(0, 1, At, B1); PG8_BAR;
            PG8_LDA(At, 1, 1); PG8_STAGE(PG8_SA(1, 0), a3, voffA);
            PG8_BAR; PG8_WAIT_L(0); PG8_MMA(1, 0, At, B0); PG8_BAR; PG8_SCHED;
            PG8_STAGE(PG8_SB(1, 1), b3 + hstep, voffB);
            PG8_WAIT_V(6); PG8_BAR; PG8_MMA(1, 1, At, B1); PG8_BAR;
            }
        }
        if constexpr (ALIGN_EPI) { if (wr == 0) PG8_BAR; }
        if constexpr (!Epi::AFTER_DRAIN) { E(acc, cur, wr, wc, fr, fq); S.done(cur); }
        if (!has_next) break;
#pragma unroll
        for (int a = 0; a < 2; ++a)
#pragma unroll
            for (int b = 0; b < 2; ++b)
#pragma unroll
                for (int m = 0; m < 4; ++m)
#pragma unroll
                    for (int n = 0; n < 2; ++n) acc[a][b][m][n] = (f32x4){0.f, 0.f, 0.f, 0.f};
        cur = nxt; cA = nA; cB = nB; ++ui;
        if constexpr (ALIGN_EPI) { if (wr == 1) PG8_BAR; }
    }
    PG8_WAIT_V(0);
    if constexpr (!ALIGN_EPI) { if (wr == 0) PG8_BAR; }
    PG8_BAR;
    if constexpr (Epi::AFTER_DRAIN) { E.fused(acc, cur, wr, wc, fr, fq, lds, wid, lane); S.done(cur); }
#undef PG8_SA
#undef PG8_SB
#undef PG8_STAGE
#undef PG8_LDA
#undef PG8_LDB
#undef PG8_MMA
#undef PG8_WAIT_V
#undef PG8_WAIT_L
#undef PG8_BAR
#undef PG8_SCHED
}
}

using pg8::bf16_t; using pg8::bf16x8; using pg8::f32x4; using pg8::u32x4; using pg8::u32x2; using pg8::cvtpk;
typedef float f32x16 __attribute__((ext_vector_type(16)));
constexpr int D = 1024, SEQ = 8192, LP = 8320, NB = 2, MP = NB * LP, MX = NB * SEQ, INW = 3584, PW = 3072, FF = 2816;
constexpr float EPS = 1e-6f;
constexpr size_t MiB = 1u << 20;
constexpr size_t WS_WIN = 1 * MiB, WS_WOUT = 8 * MiB, WS_WGU = 10 * MiB, WS_WDN = 21 * MiB;
constexpr size_t WS_U = 27 * MiB;
constexpr size_t WS_LOGF = 60 * MiB;
constexpr size_t WS_UT = 93 * MiB;
constexpr size_t WS_SPREV = 31 * MiB;
constexpr size_t WS_MIX = 110 * MiB;
constexpr size_t WS_SMALL = 142 * MiB;
constexpr size_t WS_PROJ = 144 * MiB;
constexpr int LDS_BYTES = 147456;
constexpr int NWG = 256;

__device__ __forceinline__ float bflo(unsigned w) { return __uint_as_float(w << 16); }
__device__ __forceinline__ float bfhi(unsigned w) { return __uint_as_float(w & 0xffff0000u); }
__device__ __forceinline__ float wave_sum(float v) {
#pragma unroll
    for (int o = 1; o < 64; o <<= 1) v += __shfl_xor(v, o);
    return v;
}
#define LDS_WAIT() asm volatile("s_waitcnt lgkmcnt(0)" ::: "memory")

template <int MODE> __device__ __forceinline__ void p0_transpose_item(const float* W, int K, int N, bf16_t* WT, const float* gk, float* scr, int item, int lane) {
    const int nblk = N / 32, kb = item / nblk, nb = item % nblk, k0 = 64 * kb, n0 = 32 * nb;
    float wv[32];
#pragma unroll
    for (int i = 0; i < 32; ++i) { const int kk = 2 * i + (lane >> 5); wv[i] = W[(size_t)(k0 + kk) * N + n0 + (lane & 31)]; }
#pragma unroll
    for (int i = 0; i < 32; ++i) { const int kk = 2 * i + (lane >> 5); float w = wv[i]; if (gk) w *= gk[k0 + kk]; scr[kk * 33 + (lane & 31)] = w; }
    LDS_WAIT();
    const int c = lane & 7;
#pragma unroll
    for (int j = 0; j < 4; ++j) { const int n = (lane >> 3) + 8 * j; const float* s = scr + (8 * c) * 33 + n;
        u32x4 o; o.x = cvtpk(s[0 * 33], s[1 * 33]); o.y = cvtpk(s[2 * 33], s[3 * 33]); o.z = cvtpk(s[4 * 33], s[5 * 33]); o.w = cvtpk(s[6 * 33], s[7 * 33]);
        const int nn = n0 + n; const int drow = (MODE == 0) ? nn : (((nn >> 7) << 8) + (nn & 127) + (MODE == 2 ? 128 : 0));
        *(u32x4*)(WT + (size_t)drow * K + k0 + 8 * c) = o; }
    LDS_WAIT();
}
__device__ __forceinline__ void u_rows4(int m0, const float* x, const float* meta, const float* g, bf16_t* U, int lane) {
    f32x4 v[4][4]; float s[4];
#pragma unroll
    for (int rr = 0; rr < 4; ++rr) { const int m = m0 + rr, b = m / LP, pos = m % LP;
        const float* src = pos < 112 ? nullptr : (pos < 128 ? meta + (size_t)(pos - 112) * D : x + ((size_t)b * SEQ + pos - 128) * D);
#pragma unroll
        for (int j = 0; j < 4; ++j) v[rr][j] = src ? ((const f32x4*)src)[lane + 64 * j] : (f32x4){0.f, 0.f, 0.f, 0.f}; }
#pragma unroll
    for (int rr = 0; rr < 4; ++rr) { float t = 0.f;
#pragma unroll
        for (int j = 0; j < 4; ++j) t += (v[rr][j][0] * v[rr][j][0] + v[rr][j][1] * v[rr][j][1]) + (v[rr][j][2] * v[rr][j][2] + v[rr][j][3] * v[rr][j][3]);
        s[rr] = t; }
#pragma unroll
    for (int o = 1; o < 64; o <<= 1) {
#pragma unroll
        for (int rr = 0; rr < 4; ++rr) s[rr] += __shfl_xor(s[rr], o); }
#pragma unroll
    for (int rr = 0; rr < 4; ++rr) { const float rstd = __builtin_amdgcn_rsqf(s[rr] * (1.0f / D) + EPS); bf16_t* orow = U + (size_t)(m0 + rr) * D;
#pragma unroll
        for (int j = 0; j < 4; ++j) { const f32x4 g4 = ((const f32x4*)g)[lane + 64 * j]; const f32x4 o = v[rr][j] * rstd * g4;
            u32x2 w; w.x = cvtpk(o[0], o[1]); w.y = cvtpk(o[2], o[3]); ((u32x2*)orow)[lane + 64 * j] = w; } }
}

__device__ __forceinline__ void stage_vT(const bf16_t* PROJ, size_t m0, int h, bf16_t* vT) {
    const int tid = threadIdx.x;
#pragma unroll
    for (int ii = 0; ii < 2; ++ii) { const int it = tid + 512 * ii, sp = it & 63, vc = it >> 6;
        const bf16_t* src = PROJ + (m0 + 2 * sp) * PW + 2048 + h * 128 + vc * 8;
        const u32x4 d0 = *(const u32x4*)src, d1 = *(const u32x4*)(src + PW);
#pragma unroll
        for (int j = 0; j < 4; ++j) { *(unsigned*)(vT + (vc * 8 + 2 * j) * 136 + 2 * sp) = (d0[j] & 0xffffu) | (d1[j] << 16);
            *(unsigned*)(vT + (vc * 8 + 2 * j + 1) * 136 + 2 * sp) = (d0[j] >> 16) | (d1[j] & 0xffff0000u); } }
}
__device__ __forceinline__ f32x4 exp4(f32x4 v) { return (f32x4){__expf(v[0]), __expf(v[1]), __expf(v[2]), __expf(v[3])}; }
__device__ __forceinline__ void hg_local_unit(int unit, bool light, const float* LOGF, const bf16_t* PROJ, bf16_t* KH, bf16_t* QT, bf16_t* QB, float* DB, bf16_t* UT, float* DEC, unsigned char* lds) {
    const int tid = threadIdx.x, lane = tid & 63, w = __builtin_amdgcn_readfirstlane(tid >> 6);
    const int bh = unit / 65, c = unit % 65, b = bh >> 2, h = bh & 3;
    const size_t m0 = (size_t)b * LP + (size_t)c * 128;
    bf16_t* kT = (bf16_t*)lds;
    bf16_t* vT = (bf16_t*)(lds + 34816);
    float* tot = (float*)(lds + 69632);
    const int kq = tid & 31, rg = tid >> 5;
    if (!light) stage_vT(PROJ, m0, h, vT);
    const size_t rbase = (m0 + rg * 8) * 512 + h * 128 + 4 * kq;
    f32x4 pre[8], kk[8]; u32x2 qw[8]; f32x4 run = (f32x4){0.f, 0.f, 0.f, 0.f};
#pragma unroll
    for (int i = 0; i < 8; ++i) pre[i] = *(const f32x4*)(LOGF + rbase + (size_t)i * 512);
#pragma unroll
    for (int i = 0; i < 8; ++i) qw[i] = *(const u32x2*)(PROJ + (m0 + rg * 8 + i) * PW + 1536 + h * 128 + 4 * kq);
#pragma unroll
    for (int i = 0; i < 8; ++i) { const f32x4 lf = pre[i]; run += lf; pre[i] = run; kk[i] = 1.0f - exp4(lf); }
    *(f32x4*)(tot + rg * 128 + 4 * kq) = run;
    __syncthreads();
    f32x4 off = (f32x4){0.f, 0.f, 0.f, 0.f}, Bj = off, blast = off; const int g0 = rg & ~1;
#pragma unroll
    for (int g = 0; g < 16; ++g) { const f32x4 t = *(const f32x4*)(tot + g * 128 + 4 * kq); if (g < rg) off += t; if (g < g0) Bj += t; blast += t; }
    const f32x4 Ej = Bj + *(const f32x4*)(tot + g0 * 128 + 4 * kq) + *(const f32x4*)(tot + (g0 + 1) * 128 + 4 * kq);
    const f32x4 cE = exp4(blast - Ej);
    u32x4 ktw[4];
#pragma unroll
    for (int i = 0; i < 8; i += 2) {
        const f32x4 b0 = off + pre[i], b1 = off + pre[i + 1];
        const f32x4 kh0 = kk[i] * exp4(Ej - b0), kh1 = kk[i + 1] * exp4(Ej - b1);
        const f32x4 q0 = (f32x4){bflo(qw[i].x), bfhi(qw[i].x), bflo(qw[i].y), bfhi(qw[i].y)}, q1 = (f32x4){bflo(qw[i + 1].x), bfhi(qw[i + 1].x), bflo(qw[i + 1].y), bfhi(qw[i + 1].y)};
        const f32x4 qt0 = q0 * exp4(b0 - Bj), qt1 = q1 * exp4(b1 - Bj), qb0 = q0 * exp4(b0), qb1 = q1 * exp4(b1);
        u32x2 s;
        s.x = cvtpk(kh0[0], kh0[1]); s.y = cvtpk(kh0[2], kh0[3]); *(u32x2*)(KH + rbase + (size_t)i * 512) = s;
        s.x = cvtpk(kh1[0], kh1[1]); s.y = cvtpk(kh1[2], kh1[3]); *(u32x2*)(KH + rbase + (size_t)(i + 1) * 512) = s;
        s.x = cvtpk(qt0[0], qt0[1]); s.y = cvtpk(qt0[2], qt0[3]); *(u32x2*)(QT + rbase + (size_t)i * 512) = s;
        s.x = cvtpk(qt1[0], qt1[1]); s.y = cvtpk(qt1[2], qt1[3]); *(u32x2*)(QT + rbase + (size_t)(i + 1) * 512) = s;
        s.x = cvtpk(qb0[0], qb0[1]); s.y = cvtpk(qb0[2], qb0[3]); *(u32x2*)(QB + rbase + (size_t)i * 512) = s;
        s.x = cvtpk(qb1[0], qb1[1]); s.y = cvtpk(qb1[2], qb1[3]); *(u32x2*)(QB + rbase + (size_t)(i + 1) * 512) = s;
        const f32x4 u0 = kh0 * cE, u1 = kh1 * cE;
#pragma unroll
        for (int cc = 0; cc < 4; ++cc) ktw[cc][i >> 1] = cvtpk(u0[cc], u1[cc]);
    }
#pragma unroll
    for (int cc = 0; cc < 4; ++cc) *(u32x4*)(kT + (4 * kq + cc) * 136 + rg * 8) = ktw[cc];
    if ((rg & 1) == 0) *(f32x4*)(DB + (size_t)unit * 1024 + (rg >> 1) * 128 + 4 * kq) = exp4(Ej - Bj);
    if (rg == 0) *(f32x4*)(DEC + unit * 128 + 4 * kq) = exp4(blast);
    __syncthreads();
    if (light) return;
    const int r = lane & 15, quad = lane >> 4;
    f32x4 acc[8];
#pragma unroll
    for (int vt = 0; vt < 8; ++vt) acc[vt] = (f32x4){0.f, 0.f, 0.f, 0.f};
#pragma unroll
    for (int ss = 0; ss < 4; ++ss) { const bf16x8 a = *(const bf16x8*)(kT + (16 * w + r) * 136 + 32 * ss + quad * 8);
#pragma unroll
        for (int vt = 0; vt < 8; ++vt) { const bf16x8 bb = *(const bf16x8*)(vT + (16 * vt + r) * 136 + 32 * ss + quad * 8); acc[vt] = __builtin_amdgcn_mfma_f32_16x16x32_bf16(a, bb, acc[vt], 0, 0, 0); } }
#pragma unroll
    for (int vt = 0; vt < 8; ++vt) { u32x2 o; o.x = cvtpk(acc[vt][0], acc[vt][1]); o.y = cvtpk(acc[vt][2], acc[vt][3]);
        *(u32x2*)(UT + (size_t)unit * 16384 + (16 * vt + r) * 128 + 16 * w + quad * 4) = o; }
    __syncthreads();
}

__device__ __forceinline__ void attn_unit(int au, const bf16_t* PROJ, const float* sbn, bf16_t* MIX, bf16_t* vl) {
    const int lane = threadIdx.x & 63, r32 = lane & 31, hh = lane >> 5;
    const int qt = au & 255, head = (au >> 8) & 7, b = au >> 11;
    const int q0 = 128 + 32 * qt; const size_t mb = (size_t)b * LP;
    const bf16_t* Qp = PROJ + (mb + q0 + r32) * PW + head * 64 + 8 * hh;
    bf16x8 qf[4];
#pragma unroll
    for (int ds = 0; ds < 4; ++ds) qf[ds] = *(const bf16x8*)(Qp + 16 * ds);
    f32x16 o0, o1;
#pragma unroll
    for (int i = 0; i < 16; ++i) { o0[i] = 0.f; o1[i] = 0.f; }
    float carry = 0.f; const int qpos = q0 + r32;
    const int prow = lane >> 3, pcol = (lane & 7) * 8;
    const bf16_t* Kbase = PROJ + (mb + r32) * PW + 512 + head * 64 + 8 * hh;
    const bf16_t* Vbase = PROJ + (mb + prow) * PW + 1024 + head * 64 + pcol;
    int kt = q0 >> 5;
    bf16x8 kn[4]; u32x4 vn[4];
#pragma unroll
    for (int ds = 0; ds < 4; ++ds) kn[ds] = *(const bf16x8*)(Kbase + (size_t)(32 * kt) * PW + 16 * ds);
#pragma unroll
    for (int i = 0; i < 4; ++i) vn[i] = *(const u32x4*)(Vbase + (size_t)(32 * kt + 8 * i) * PW);
    for (;;) {
        const int kv0 = 32 * kt; const bool more = kt > 3;
        bf16x8 kf[4];
#pragma unroll
        for (int ds = 0; ds < 4; ++ds) kf[ds] = kn[ds];
#pragma unroll
        for (int i = 0; i < 4; ++i) *(u32x4*)(vl + (prow + 8 * i) * 72 + pcol) = vn[i];
        asm volatile("" ::: "memory");
        if (more) {
#pragma unroll
            for (int ds = 0; ds < 4; ++ds) kn[ds] = *(const bf16x8*)(Kbase + (size_t)(kv0 - 32) * PW + 16 * ds);
#pragma unroll
            for (int i = 0; i < 4; ++i) vn[i] = *(const u32x4*)(Vbase + (size_t)(kv0 - 32 + 8 * i) * PW);
        }
        f32x16 x;
#pragma unroll
        for (int i = 0; i < 16; ++i) x[i] = 0.f;
#pragma unroll
        for (int ds = 0; ds < 4; ++ds) x = __builtin_amdgcn_mfma_f32_32x32x16_bf16(kf[ds], qf[ds], x, 0, 0, 0);
        float be[16], om[16];
        const bool edge = (kt == (q0 >> 5)) || (kt == 3);
#pragma unroll
        for (int i = 0; i < 16; ++i) { const float zp = x[i]; const float u = __builtin_amdgcn_exp2f(-fabsf(zp)); const float s = __builtin_amdgcn_rcpf(1.0f + u), us = u * s;
            be[i] = zp > 0.f ? s : us; om[i] = zp > 0.f ? us : s; }
        if (edge) {
#pragma unroll
            for (int i = 0; i < 16; ++i) { const int kv = kv0 + (i & 3) + 8 * (i >> 2) + 4 * hh; const bool vis = (kv < qpos) && (kv >= 112); be[i] = vis ? be[i] : 0.f; om[i] = vis ? om[i] : 1.0f; } }
        float gp[4], pp[4], T[4]; float run = 1.0f;
#pragma unroll
        for (int g = 0; g < 4; ++g) gp[g] = (om[4 * g] * om[4 * g + 1]) * (om[4 * g + 2] * om[4 * g + 3]);
#pragma unroll
        for (int g = 0; g < 4; ++g) pp[g] = __shfl_xor(gp[g], 32);
#pragma unroll
        for (int g = 3; g >= 0; --g) { T[g] = hh == 0 ? run * pp[g] : run; run *= gp[g] * pp[g]; }
        const float C = __builtin_amdgcn_exp2f(carry);
        float wv[16];
#pragma unroll
        for (int g = 0; g < 4; ++g) { float a = C * T[g];
#pragma unroll
            for (int e = 3; e >= 0; --e) { const int i = 4 * g + e; wv[i] = be[i] * a; a *= om[i]; } }
        carry += __builtin_amdgcn_logf(run);
        bf16x8 xs[2];
#pragma unroll
        for (int s = 0; s < 2; ++s) { u32x4 pw; pw.x = cvtpk(wv[8 * s], wv[8 * s + 1]); pw.y = cvtpk(wv[8 * s + 2], wv[8 * s + 3]); pw.z = cvtpk(wv[8 * s + 4], wv[8 * s + 5]); pw.w = cvtpk(wv[8 * s + 6], wv[8 * s + 7]);
            xs[s] = __builtin_bit_cast(bf16x8, pw); }
        const bf16_t* vp = vl + (4 * hh) * 72 + r32;
#pragma unroll
        for (int s = 0; s < 2; ++s) {
            bf16x8 va, vb;
#pragma unroll
            for (int j = 0; j < 8; ++j) { const bf16_t* p = vp + (16 * s + 8 * (j >> 2) + (j & 3)) * 72; va[j] = (short)p[0]; vb[j] = (short)p[32]; }
            o0 = __builtin_amdgcn_mfma_f32_32x32x16_bf16(va, xs[s], o0, 0, 0, 0);
            o1 = __builtin_amdgcn_mfma_f32_32x32x16_bf16(vb, xs[s], o1, 0, 0, 0);
        }
        asm volatile("" ::: "memory");
        if (!more || __all(carry < -152.0f)) break;
        --kt;
    }
    float ss = 0.f;
#pragma unroll
    for (int i = 0; i < 16; ++i) ss += o0[i] * o0[i] + o1[i] * o1[i];
    ss += __shfl_xor(ss, 32);
    const float rstd = 1.0f / sqrtf(ss * (1.0f / 64.0f) + EPS);
    bf16_t* orow = MIX + ((size_t)b * SEQ + q0 - 128 + r32) * D + head * 64;
#pragma unroll
    for (int g = 0; g < 4; ++g) { const int d0 = 8 * g + 4 * hh;
        const f32x4 g0 = *(const f32x4*)(sbn + head * 64 + d0), g1 = *(const f32x4*)(sbn + head * 64 + 32 + d0);
        u32x2 w0, w1;
        w0.x = cvtpk(o0[4 * g] * rstd * g0[0], o0[4 * g + 1] * rstd * g0[1]); w0.y = cvtpk(o0[4 * g + 2] * rstd * g0[2], o0[4 * g + 3] * rstd * g0[3]);
        w1.x = cvtpk(o1[4 * g] * rstd * g1[0], o1[4 * g + 1] * rstd * g1[1]); w1.y = cvtpk(o1[4 * g + 2] * rstd * g1[2], o1[4 * g + 3] * rstd * g1[3]);
        *(u32x2*)(orow + d0) = w0; *(u32x2*)(orow + 32 + d0) = w1; }
}

__device__ __forceinline__ void hg_out_stage(int bh, int c, const bf16_t* PROJ, const bf16_t* UT, unsigned char* lds) {
    const int tid = threadIdx.x; const int b = bh >> 2, h = bh & 3, unit = bh * 65 + c;
    const size_t m0 = (size_t)b * LP + (size_t)c * 128;
    stage_vT(PROJ, m0, h, (bf16_t*)lds);
    bf16_t* sT = (bf16_t*)(lds + 34816);
#pragma unroll
    for (int ii = 0; ii < 4; ++ii) { const int p = tid + 512 * ii, s = p >> 4, vc = p & 15;
        const u32x4 e = *(const u32x4*)(UT + (size_t)unit * 16384 + s * 128 + vc * 8); *(u32x4*)(sT + s * 136 + vc * 8) = e; }
}
__device__ __forceinline__ void hg_out_wave(int bh, int c, int i, const bf16_t* KH, const bf16_t* QT, const bf16_t* QB, const float* DB, const bf16_t* PROJ, const float* hgn, bf16_t* MIX, const unsigned char* lds) {
    const int lane = threadIdx.x & 63, r = lane & 15, quad = lane >> 4;
    const int b = bh >> 2, h = bh & 3, unit = bh * 65 + c;
    const size_t m0 = (size_t)b * LP + (size_t)c * 128;
    const bf16_t* vT = (const bf16_t*)lds; const bf16_t* sT = (const bf16_t*)(lds + 34816);
    const size_t mt = m0 + 16 * i + r; const int kc = h * 128 + quad * 8;
    const bf16_t* KHl = KH + (m0 + r) * 512 + kc;
    const float* DBl = DB + (size_t)unit * 1024 + quad * 8;
    bf16x8 qtl[4], qbr[4]; float g[4][8]; u32x4 khn[4]; f32x4 dn[4][2];
#pragma unroll
    for (int ks = 0; ks < 4; ++ks) { qtl[ks] = *(const bf16x8*)(QT + mt * 512 + kc + 32 * ks); qbr[ks] = *(const bf16x8*)(QB + mt * 512 + kc + 32 * ks);
        khn[ks] = *(const u32x4*)(KHl + (size_t)(16 * i) * 512 + 32 * ks);
        const float* dp = DBl + i * 128 + 32 * ks; dn[ks][0] = *(const f32x4*)dp; dn[ks][1] = *(const f32x4*)(dp + 4); }
    f32x4 o[8];
#pragma unroll
    for (int vt = 0; vt < 8; ++vt) o[vt] = (f32x4){0.f, 0.f, 0.f, 0.f};
    f32x4 scA = (f32x4){0.f, 0.f, 0.f, 0.f}, scB = scA; int jA = i;
    for (int jb = i; jb >= 0; --jb) {
        const int mode = (jb == i) ? 0 : ((jb == i - 1) ? 1 : 2);
        u32x4 kh[4];
#pragma unroll
        for (int ks = 0; ks < 4; ++ks) { kh[ks] = khn[ks];
            if (mode == 0) {
#pragma unroll
                for (int j = 0; j < 4; ++j) { g[ks][j] = __builtin_amdgcn_rcpf(fmaxf(dn[ks][0][j], 1e-30f)); g[ks][4 + j] = __builtin_amdgcn_rcpf(fmaxf(dn[ks][1][j], 1e-30f)); } }
            else if (mode == 2) {
#pragma unroll
                for (int j = 0; j < 4; ++j) { g[ks][j] *= dn[ks][0][j]; g[ks][4 + j] *= dn[ks][1][j]; } } }
        if (jb > 0) {
#pragma unroll
            for (int ks = 0; ks < 4; ++ks) { khn[ks] = *(const u32x4*)(KHl + (size_t)(16 * (jb - 1)) * 512 + 32 * ks);
                const float* dp = DBl + jb * 128 + 32 * ks; dn[ks][0] = *(const f32x4*)dp; dn[ks][1] = *(const f32x4*)(dp + 4); } }
        f32x4 sc = (f32x4){0.f, 0.f, 0.f, 0.f};
#pragma unroll
        for (int ks = 0; ks < 4; ++ks) { u32x4 t = kh[ks];
            if (mode != 1) {
#pragma unroll
                for (int j = 0; j < 4; ++j) t[j] = cvtpk(bflo(kh[ks][j]) * g[ks][2 * j], bfhi(kh[ks][j]) * g[ks][2 * j + 1]); }
            sc = __builtin_amdgcn_mfma_f32_16x16x32_bf16(__builtin_bit_cast(bf16x8, t), qtl[ks], sc, 0, 0, 0); }
        if (mode == 0) {
#pragma unroll
            for (int jj = 0; jj < 4; ++jj) if (quad * 4 + jj > r) sc[jj] = 0.f;
#pragma unroll
            for (int ks = 0; ks < 4; ++ks)
#pragma unroll
                for (int j = 0; j < 8; ++j) g[ks][j] = 1.0f; }
        const bool second = ((i - jb) & 1) != 0;
        if (!second) { scA = sc; jA = jb; scB = (f32x4){0.f, 0.f, 0.f, 0.f}; } else scB = sc;
        if (second || jb == 0) {
            u32x4 pp; pp.x = cvtpk(scA[0], scA[1]); pp.y = cvtpk(scA[2], scA[3]); pp.z = cvtpk(scB[0], scB[1]); pp.w = cvtpk(scB[2], scB[3]);
            const bf16x8 pf = __builtin_bit_cast(bf16x8, pp);
            const int cA = 16 * jA + quad * 4, cB = 16 * jb + quad * 4;
#pragma unroll
            for (int vt = 0; vt < 8; ++vt) { const bf16_t* vp = vT + (16 * vt + r) * 136;
                const u32x2 a0 = *(const u32x2*)(vp + cA), a1 = *(const u32x2*)(vp + cB); u32x4 av; av.x = a0.x; av.y = a0.y; av.z = a1.x; av.w = a1.y;
                o[vt] = __builtin_amdgcn_mfma_f32_16x16x32_bf16(__builtin_bit_cast(bf16x8, av), pf, o[vt], 0, 0, 0); }
        }
    }
#pragma unroll
    for (int ks = 0; ks < 4; ++ks)
#pragma unroll
        for (int vt = 0; vt < 8; ++vt) { const bf16x8 sf = *(const bf16x8*)(sT + (16 * vt + r) * 136 + 32 * ks + quad * 8); o[vt] = __builtin_amdgcn_mfma_f32_16x16x32_bf16(sf, qbr[ks], o[vt], 0, 0, 0); }
    float ss = 0.f;
#pragma unroll
    for (int vt = 0; vt < 8; ++vt) ss += (o[vt][0] * o[vt][0] + o[vt][1] * o[vt][1]) + (o[vt][2] * o[vt][2] + o[vt][3] * o[vt][3]);
    ss += __shfl_xor(ss, 16); ss += __shfl_xor(ss, 32);
    const float rstd = __builtin_amdgcn_rsqf(ss * (1.0f / 128.0f) + EPS);
    const bf16_t* gp = PROJ + mt * PW + 2560 + h * 128 + quad * 4;
    bf16_t* op = MIX + ((size_t)b * SEQ + (size_t)c * 128 - 128 + 16 * i + r) * D + 512 + h * 128 + quad * 4;
#pragma unroll
    for (int vt = 0; vt < 8; ++vt) { const u32x2 gw = *(const u32x2*)(gp + 16 * vt); const f32x4 gn = *(const f32x4*)(hgn + h * 128 + 16 * vt + quad * 4);
        const float g0 = bflo(gw.x), g1 = bfhi(gw.x), g2 = bflo(gw.y), g3 = bfhi(gw.y);
        u32x2 ow; ow.x = cvtpk(o[vt][0] * rstd * gn[0] * (g0 * __builtin_amdgcn_rcpf(1.0f + __expf(-g0))), o[vt][1] * rstd * gn[1] * (g1 * __builtin_amdgcn_rcpf(1.0f + __expf(-g1))));
        ow.y = cvtpk(o[vt][2] * rstd * gn[2] * (g2 * __builtin_amdgcn_rcpf(1.0f + __expf(-g2))), o[vt][3] * rstd * gn[3] * (g3 * __builtin_amdgcn_rcpf(1.0f + __expf(-g3))));
        *(u32x2*)(op + 16 * vt) = ow; }
}

#define LAS __attribute__((address_space(3)))
#define XB_TMO      128
#define XB_XCNT(j)  (256  + 64 * (j))
#define XB_XSUB(j)  (1280 + 64 * (j))
#define XB_XGEN(j)  (2304 + 64 * (j))
#define XB_TOP      3328
#define XB_TOPGEN   3392
#define XCD_BAR_WORDS 3456
#define XB_SPIN_CAP (1u << 18)

__device__ __forceinline__ unsigned xb_ld(unsigned* p)              { return __hip_atomic_load(p, __ATOMIC_RELAXED, __HIP_MEMORY_SCOPE_AGENT); }
__device__ __forceinline__ unsigned xb_add(unsigned* p, unsigned v) { return __hip_atomic_fetch_add(p, v, __ATOMIC_RELAXED, __HIP_MEMORY_SCOPE_AGENT); }
__device__ __forceinline__ unsigned xb_xcc_id() { return (unsigned)__builtin_amdgcn_s_getreg((3 << 11) | 20) & 0xFu; }
#define XB_SPIN(cond, bar) do { unsigned _sp = 0; while (cond) { __builtin_amdgcn_s_sleep(1); \
    if ((++_sp & 255u) == 0u) { if (xb_ld(&(bar)[XB_TMO])) break; if (_sp > XB_SPIN_CAP) { atomicAdd(&(bar)[XB_TMO], 1u); break; } } } } while (0)

struct XcdBarrier {
    unsigned* bar; unsigned x;
    volatile LAS unsigned* st;
};

__device__ __forceinline__ XcdBarrier xcd_barrier_post(unsigned* bar, volatile LAS unsigned* st) {
    XcdBarrier b; b.bar = bar; b.x = xb_xcc_id(); b.st = st;
    if (threadIdx.x == 0) (void)xb_add(&bar[XB_XCNT(b.x)], 1u);
    return b;
}
__device__ __forceinline__ void xcd_barrier_complete(unsigned* bar, unsigned x, unsigned& nloc, unsigned& nx) {
    const unsigned G = gridDim.x * gridDim.y * gridDim.z;
    unsigned sum, cnt, mine, sp = 0u;
    for (;;) {
        sum = 0u; cnt = 0u; mine = 0u;
#pragma unroll
        for (unsigned j = 0; j < 16; ++j) { const unsigned c = xb_ld(&bar[XB_XCNT(j)]); sum += c; cnt += (c > 0u) ? 1u : 0u; mine = (j == x) ? c : mine; }
        if (sum == G) break;
        __builtin_amdgcn_s_sleep(1);
        if ((++sp & 255u) == 0u) { if (xb_ld(&bar[XB_TMO])) break; if (sp > XB_SPIN_CAP) { atomicAdd(&bar[XB_TMO], 1u); break; } }
    }
    nloc = mine > 0u ? mine : 1u; nx = cnt > 0u ? cnt : 1u;
}

__device__ __forceinline__ void xcd_barrier(const XcdBarrier& b) {
    asm volatile("s_waitcnt vmcnt(0)" ::: "memory");
    __syncthreads();
    if (threadIdx.x == 0) {
        unsigned* bar = b.bar;
        __builtin_amdgcn_s_waitcnt(0);
        unsigned nloc = b.st[0], nx = b.st[1];
        if (nloc == 0u) { xcd_barrier_complete(bar, b.x, nloc, nx); b.st[0] = nloc; b.st[1] = nx; }
        const unsigned old = xb_add(&bar[XB_XSUB(b.x)], 1u);
        const unsigned gen = old / nloc;
        if (old + 1u == (gen + 1u) * nloc) {
            __builtin_amdgcn_fence(__ATOMIC_RELEASE, "agent");
            asm volatile("s_waitcnt vmcnt(0)" ::: "memory");
            const unsigned og = xb_add(&bar[XB_TOP], 1u);
            const unsigned tg = og / nx;
            if (og + 1u == (tg + 1u) * nx) xb_add(&bar[XB_TOPGEN], 1u);
            else XB_SPIN(xb_ld(&bar[XB_TOPGEN]) == tg, bar);
            __builtin_amdgcn_fence(__ATOMIC_ACQUIRE, "agent");
            xb_add(&bar[XB_XGEN(b.x)], 1u);
            asm volatile("s_waitcnt vmcnt(0)" ::: "memory");
        } else {
            XB_SPIN(xb_ld(&bar[XB_XGEN(b.x)]) == gen, bar);
            __builtin_amdgcn_fence(__ATOMIC_ACQUIRE, "agent");
            asm volatile("s_waitcnt vmcnt(0)" ::: "memory");
        }
    }
    __syncthreads();
}

#ifndef REP_HL
#define REP_HL 1
#endif
#ifndef REP_AT
#define REP_AT 1
#endif
#ifndef REP_P2C
#define REP_P2C 1
#endif
#ifndef REP_SYNC
#define REP_SYNC 1
#endif
#ifndef REP_P0
#define REP_P0 1
#endif
#ifndef REP_P3
#define REP_P3 1
#endif
#ifndef REP_P5
#define REP_P5 1
#endif
#ifndef REP_P2B
#define REP_P2B 1
#endif
#ifndef REP_P1
#define REP_P1 1
#endif
#ifndef REP_P4
#define REP_P4 1
#endif
#define GSYNC() do { for (int rs_ = 0; rs_ < REP_SYNC; ++rs_) xcd_barrier(xbar); } while (0)
struct Args { const float* in[13]; float* out; unsigned char* ws; long long pad; };
__global__ void __launch_bounds__(512, 2) hybrid_fwd(Args a) {
    extern __shared__ __attribute__((aligned(16))) unsigned char lds[];
    cg::grid_group grid = cg::this_grid();
    const int tid = threadIdx.x, lane = tid & 63, wave = __builtin_amdgcn_readfirstlane(tid >> 6);
    const int G = gridDim.x, bx = blockIdx.x;
    typedef const __attribute__((address_space(4))) unsigned char* kptr_t;
    kptr_t kp = (kptr_t)__builtin_amdgcn_kernarg_segment_ptr();
#define KIN(i) (*(const float* const __attribute__((address_space(4)))*)(kp + 8 * (i)))
#define PH_BEGIN() asm volatile("" : "+s"(kp)); unsigned char* const ws = *(unsigned char* const __attribute__((address_space(4)))*)(kp + 112)
#define W_BF(off) ((bf16_t*)(ws + (off)))
#define W_F32(off) ((float*)(ws + (off)))
    volatile LAS unsigned* bst = (volatile LAS unsigned*)((LAS unsigned char*)lds + LDS_BYTES - 64);
    if (tid == 0) { bst[0] = 0u; bst[1] = 0u; }
    __syncthreads();
    const XcdBarrier xbar = xcd_barrier_post((unsigned*)a.ws, bst);
    PG8_LAS unsigned char* ldsp = (PG8_LAS unsigned char*)lds;

    {
        PH_BEGIN(); const float *x = KIN(0), *meta = KIN(1), *n1g = KIN(2), *w_in = KIN(3), *w_out = KIN(7), *n2g = KIN(8), *w_gate = KIN(9), *w_up = KIN(10), *w_down = KIN(11);
        bf16_t *Win_t = W_BF(WS_WIN), *Wout_t = W_BF(WS_WOUT), *Wgu_t = W_BF(WS_WGU), *Wdn_t = W_BF(WS_WDN), *U = W_BF(WS_U);
        float* scr = (float*)(lds + wave * 16384);
        const int gw = bx * 8 + wave, NGW = G * 8;
        constexpr int I_IN = (D / 64) * (INW / 32), I_OUT = (D / 64) * (D / 32), I_G = (D / 64) * (FF / 32), I_DN = (FF / 64) * (D / 32);
        constexpr int NITEMS = I_IN + I_OUT + 2 * I_G + I_DN;
        for (int it = gw; it < NITEMS * REP_P0; it += NGW) {
            int r = it % NITEMS;
            if (r < I_IN) { p0_transpose_item<0>(w_in, D, INW, Win_t, nullptr, scr, r, lane); continue; } r -= I_IN;
            if (r < I_OUT) { p0_transpose_item<0>(w_out, D, D, Wout_t, nullptr, scr, r, lane); continue; } r -= I_OUT;
            if (r < I_G) { p0_transpose_item<1>(w_gate, D, FF, Wgu_t, n2g, scr, r, lane); continue; } r -= I_G;
            if (r < I_G) { p0_transpose_item<2>(w_up, D, FF, Wgu_t, n2g, scr, r, lane); continue; } r -= I_G;
            p0_transpose_item<0>(w_down, FF, D, Wdn_t, nullptr, scr, r, lane);
        }
        for (int mm = gw * 4; mm < MP * REP_P0; mm += NGW * 4) u_rows4(mm % MP, x, meta, n1g, U, lane);
    }
    if (a.pad != 0) grid.sync();
    GSYNC();
    {
        PH_BEGIN(); const float* lbl = KIN(6); bf16_t *U = W_BF(WS_U), *Win_t = W_BF(WS_WIN), *PROJ = W_BF(WS_PROJ); float* LOGF = W_F32(WS_LOGF);
        pg8::Gemm g{U, Win_t, MP, INW, D}; pg8::StaticOrder S; S.init(MP, INW, G, bx); S.rep = REP_P1;
        pg8::EpiProj E{PROJ, LOGF, lbl};
        pg8::gemm_phase<pg8::EpiProj, pg8::StaticOrder, true, true>(ldsp, g, S, E);
    }
    GSYNC();
    {
        PH_BEGIN(); const float* sbn = KIN(4); bf16_t *PROJ = W_BF(WS_PROJ), *UT = W_BF(WS_UT), *MIX = W_BF(WS_MIX); float *LOGF = W_F32(WS_LOGF), *DB = W_F32(WS_U), *DEC = W_F32(WS_SMALL);
        bf16_t* KH = *(bf16_t* const __attribute__((address_space(4)))*)(kp + 104); bf16_t *QT = KH + (size_t)MP * 512, *QB = KH + (size_t)MP * 1024;
        for (int uu = bx; uu < 512 * REP_HL; uu += G) hg_local_unit(((uu >> 6) & 7) * 65 + (uu & 63), false, LOGF, PROJ, KH, QT, QB, DB, UT, DEC, lds);
        for (int uu = bx; uu < 8; uu += G) hg_local_unit(uu * 65 + 64, true, LOGF, PROJ, KH, QT, QB, DB, UT, DEC, lds);
        for (int au = bx * 8 + wave; au < 4096 * REP_AT; au += G * 8) attn_unit(au & 4095, PROJ, sbn, MIX, (bf16_t*)(lds + 73728 + wave * 4608));
    }
    GSYNC();
    {
        PH_BEGIN(); const bf16_t* __restrict__ UT = W_BF(WS_UT); bf16_t* __restrict__ SP = W_BF(WS_SPREV); const float* __restrict__ DEC = W_F32(WS_SMALL);
        for (int rb = 0; rb < REP_P2B; ++rb) {
        const int gid = bx * 512 + tid;
        if (gid < 65536) { const int bh = gid >> 13, e2 = gid & 8191, k2 = (2 * e2) & 127;
            float s0 = 0.f, s1 = 0.f;
            for (int c0 = 0; c0 < 64; c0 += 32) {
                unsigned uu[32]; float d0[32], d1[32];
#pragma unroll
                for (int j = 0; j < 32; ++j) { const int unit = bh * 65 + c0 + j; uu[j] = *((const unsigned*)(UT + (size_t)unit * 16384) + e2);
                    const float2 dd = *(const float2*)(DEC + unit * 128 + k2); d0[j] = dd.x; d1[j] = dd.y; }
#pragma unroll
                for (int j = 0; j < 32; ++j) { const int unit = bh * 65 + c0 + j; *((unsigned*)(SP + (size_t)unit * 16384) + e2) = cvtpk(s0, s1);
                    s0 = d0[j] * s0 + bflo(uu[j]); s1 = d1[j] * s1 + bfhi(uu[j]); }
            }
            *((unsigned*)(SP + (size_t)(bh * 65 + 64) * 16384) + e2) = cvtpk(s0, s1);
        }
        }
    }
    GSYNC();
    {
        PH_BEGIN(); const float* hgn = KIN(5); bf16_t *PROJ = W_BF(WS_PROJ), *UT = W_BF(WS_SPREV), *MIX = W_BF(WS_MIX); const float* DB = W_F32(WS_U);
        const bf16_t* KH = *(bf16_t* const __attribute__((address_space(4)))*)(kp + 104); const bf16_t *QT = KH + (size_t)MP * 512, *QB = KH + (size_t)MP * 1024;
        for (int rr = 0; rr < REP_P2C; ++rr) {
            const int bhA = bx >> 6, bhB = 4 + (bx >> 6), cc = (bx & 63) + 1;
            hg_out_stage(bhA, cc, PROJ, UT, lds); hg_out_stage(bhB, cc, PROJ, UT, lds + 69632);
            __syncthreads();
            hg_out_wave(bhA, cc, wave, KH, QT, QB, DB, PROJ, hgn, MIX, lds);
            hg_out_wave(bhB, cc, 7 - wave, KH, QT, QB, DB, PROJ, hgn, MIX, lds + 69632);
            __syncthreads();
        }
    }
    GSYNC();
    {
        PH_BEGIN(); const float* x = KIN(0); float* out = *(float* const __attribute__((address_space(4)))*)(kp + 104); bf16_t *MIX = W_BF(WS_MIX), *Wout_t = W_BF(WS_WOUT), *H2B = W_BF(WS_LOGF); float* SS2 = W_F32(WS_SMALL + 512 * 1024);
        pg8::Gemm g{MIX, Wout_t, MX, D, D}; pg8::StaticOrder S; S.init(MX, D, G, bx); S.rep = REP_P3;
        pg8::EpiResid E{x, nullptr, H2B, SS2};
        pg8::gemm_phase<pg8::EpiResid, pg8::StaticOrder, false, true>(ldsp, g, S, E);
    }
    GSYNC();
    {
        PH_BEGIN(); bf16_t *H2B = W_BF(WS_LOGF), *Wgu_t = W_BF(WS_WGU), *HID = W_BF(WS_PROJ); float* SS2 = W_F32(WS_SMALL + 512 * 1024);
        pg8::Gemm g{H2B, Wgu_t, MX, 2 * FF, D}; pg8::StaticOrder S; S.init(MX, 2 * FF, G, bx); S.rep = REP_P4;
        pg8::EpiSwiglu E{HID, SS2};
        pg8::gemm_phase<pg8::EpiSwiglu, pg8::StaticOrder, true, true>(ldsp, g, S, E);
    }
    GSYNC();
    {
        PH_BEGIN(); const float* fng = KIN(12); float* out = *(float* const __attribute__((address_space(4)))*)(kp + 104); bf16_t *HID = W_BF(WS_PROJ), *Wdn_t = W_BF(WS_WDN); float* SS3 = W_F32(WS_SMALL + 768 * 1024);
        pg8::Gemm g{HID, Wdn_t, MX, D, FF}; pg8::StaticOrder S; S.init(MX, D, G, bx); S.rep = REP_P5;
        pg8::EpiFinal E{W_BF(WS_LOGF), out, SS3, (unsigned*)(ws + 16384), fng};
        pg8::gemm_phase<pg8::EpiFinal, pg8::StaticOrder, false, true>(ldsp, g, S, E);
    }
}

extern "C" void kernel_launch(void* const* d_in, const int* in_sizes, int n_in, void* d_out, int out_size, void* d_ws, size_t ws_size, hipStream_t stream) {
    static int ready = 0;
    if (!ready) {
        if (n_in != 13 || out_size != MX * D || ws_size < 242 * MiB) { fprintf(stderr, "kernel_launch: unexpected problem shape (n_in %d, out %d, ws %zu)\n", n_in, out_size, ws_size); ready = -1; return; }
        if (hipFuncSetAttribute((const void*)hybrid_fwd, hipFuncAttributeMaxDynamicSharedMemorySize, LDS_BYTES) != hipSuccess) { fprintf(stderr, "kernel_launch: hipFuncSetAttribute failed\n"); ready = -1; return; }
        ready = 1;
    }
    if (ready < 0) return;
    Args a{};
    for (int i = 0; i < 13; ++i) a.in[i] = (const float*)d_in[i];
    a.out = (float*)d_out; a.ws = (unsigned char*)d_ws; a.pad = 0;
    if (hipMemsetAsync(d_ws, 0, 32768, stream) != hipSuccess) { fprintf(stderr, "kernel_launch: memset failed\n"); return; }
    void* args[] = {&a};
    const hipError_t e = hipLaunchCooperativeKernel((const void*)hybrid_fwd, dim3(NWG), dim3(512), args, LDS_BYTES, stream);
    if (e != hipSuccess) fprintf(stderr, "kernel_launch: cooperative launch failed: %s\n", hipGetErrorString(e));
}
```

```cpp
#include <hip/hip_runtime.h>
#include <hip/hip_cooperative_groups.h>
#include <cstdio>
#include <cstdint>
namespace cg = cooperative_groups;
namespace pg8 {
#define PG8_LAS __attribute__((address_space(3)))
typedef unsigned short bf16_t;
typedef short bf16x8 __attribute__((ext_vector_type(8)));
typedef float f32x4 __attribute__((ext_vector_type(4)));
typedef unsigned u32x4 __attribute__((ext_vector_type(4)));
constexpr int BM = 256, BK = 64, HALF = 128, HTB = HALF * BK * 2  , STAGE_BYTES = 8 * HTB, NXCD = 8, WGM = 8;

__host__ __device__ __forceinline__ int lds_byte(int r, int c) { const int st = (r >> 4) * 2 + (c >> 5), rr = r & 15, cc = c & 31, ob = rr * 64 + cc * 2; return st * 1024 + (ob ^ (((ob >> 9) & 1) << 5)); }
__host__ __device__ __forceinline__ void stage_rc(int b, int& R, int& C) { const int st = b / 1024, sb = b % 1024, swz = sb ^ (((sb >> 9) & 1) << 5); R = (st >> 1) * 16 + swz / 64; C = (st & 1) * 32 + (swz % 64) / 2; }
__host__ __device__ __forceinline__ int perm32(int rho) { const int n = rho >> 4, i = rho & 15; return 8 * (i >> 2) + 4 * n + (i & 3); }

struct Unit { int pm, pn; };
struct Gemm { const bf16_t* A; const bf16_t* Bt; int M, N, K; };

struct StaticOrder {
    int nM, nN, nwg, G, c, rep;
    __host__ __device__ void init(int M, int N, int G_, int c_) { nM = M / BM; nN = N / BM; nwg = nM * nN; G = G_; c = c_; rep = 1; }
    __host__ __device__ bool next(int i, Unit& u) const {
        const long L = (long)i * G + c; if (L >= (long)nwg * rep) return false;
        int wgid = (int)(L % nwg); { const int q = nwg / NXCD, r = nwg % NXCD, xcd = wgid % NXCD, off = wgid / NXCD; wgid = (xcd < r ? xcd * (q + 1) : r * (q + 1) + (xcd - r) * q) + off; }
        const int nig = WGM * nN, gid = wgid / nig, fm = gid * WGM, gsz = (nM - fm) < WGM ? (nM - fm) : WGM;
        u.pm = fm + ((wgid % nig) % gsz); u.pn = (wgid % nig) / gsz; return true;
    }
    __device__ __forceinline__ void a_ready(const Unit&) const {}
    __device__ __forceinline__ void done(const Unit&) const {}
};

__device__ __forceinline__ unsigned cvt_pk_bf16(float lo, float hi) { unsigned r; asm volatile("v_cvt_pk_bf16_f32 %0, %1, %2" : "=v"(r) : "v"(lo), "v"(hi)); return r; }
typedef float f32x2 __attribute__((ext_vector_type(2)));
typedef float f32x2_t __attribute__((ext_vector_type(2))); typedef __bf16 bf16x2_t __attribute__((ext_vector_type(2)));
__device__ __forceinline__ unsigned cvtpk(float lo, float hi) { f32x2_t v = {lo, hi}; bf16x2_t b = __builtin_convertvector(v, bf16x2_t); return __builtin_bit_cast(unsigned, b); }
typedef unsigned u32x2 __attribute__((ext_vector_type(2)));

struct EpiProj {
    static constexpr bool PERM = true, AFTER_DRAIN = false;
    bf16_t* proj; float* logf; const float* lbl;
    __device__ __forceinline__ void operator()(const f32x4 (&acc)[2][2][4][2], const Unit& u, int wr, int wc, int fr, int fq) const {
        const int row0 = u.pm * BM + wr * 64 + fr, colt = u.pn * BM, seg = colt >> 9;
        if (seg != 4) {
            const float sc = (seg == 0) ? 0.18033688011112042f : 1.f;
            const int pc = (colt < 2048 ? colt : colt - 512) + wc * 32 + 8 * fq;
#pragma unroll
            for (int ai = 0; ai < 2; ++ai)
#pragma unroll
                for (int m = 0; m < 4; ++m) { bf16_t* rowp = proj + (size_t)(row0 + ai * HALF + m * 16) * 3072 + pc;
#pragma unroll
                    for (int bj = 0; bj < 2; ++bj) { const f32x4 v0 = acc[ai][bj][m][0] * sc, v1 = acc[ai][bj][m][1] * sc;
                        u32x4 w; w.x = cvtpk(v0[0], v0[1]); w.y = cvtpk(v0[2], v0[3]); w.z = cvtpk(v1[0], v1[1]); w.w = cvtpk(v1[2], v1[3]);
                        *(u32x4*)(rowp + bj * HALF) = w; } }
        } else {
            const int c0 = colt - 2048 + wc * 32 + 8 * fq;
            float oml[2][8];
#pragma unroll
            for (int bj = 0; bj < 2; ++bj)
#pragma unroll
                for (int e = 0; e < 8; ++e) { const int c = c0 + bj * HALF + e; oml[bj][e] = 1.0f / (1.0f + __expf(lbl[c] - lbl[512 + c])); }
#pragma unroll
            for (int ai = 0; ai < 2; ++ai)
#pragma unroll
                for (int m = 0; m < 4; ++m) { const int row = row0 + ai * HALF + m * 16; const bool valid = (row % 8320) >= 112; float* rowp = logf + (size_t)row * 512 + c0;
#pragma unroll
                    for (int bj = 0; bj < 2; ++bj)
#pragma unroll
                        for (int n = 0; n < 2; ++n) { f32x4 o;
#pragma unroll
                            for (int e = 0; e < 4; ++e) { const float f = acc[ai][bj][m][n][e]; const float k = oml[bj][4 * n + e] * __builtin_amdgcn_rcpf(1.0f + __expf(f)); o[e] = valid ? __logf(1.0f - k) : 0.f; }
                            *(f32x4*)(rowp + bj * HALF + 4 * n) = o; } }
        }
    }
};

struct EpiResid {
    static constexpr bool PERM = false, AFTER_DRAIN = true;
    const float* base; float* out; bf16_t* outb; float* ss;
    __device__ __forceinline__ void init(f32x4 (&acc)[2][2][4][2], const Unit& u, int wr, int wc, int fr, int fq) const {
        const int col0 = u.pn * BM + wc * 32 + 4 * fq;
#pragma unroll
        for (int ai = 0; ai < 2; ++ai)
#pragma unroll
            for (int m = 0; m < 4; ++m) { const size_t off = (size_t)(u.pm * BM + ai * HALF + wr * 64 + m * 16 + fr) * 1024 + col0;
#pragma unroll
                for (int bj = 0; bj < 2; ++bj)
#pragma unroll
                    for (int n = 0; n < 2; ++n) acc[ai][bj][m][n] = __builtin_nontemporal_load((const f32x4*)(base + off + bj * HALF + n * 16)); }
    }
    __device__ __forceinline__ void fused(f32x4 (&acc)[2][2][4][2], const Unit& u, int wr, int wc, int fr, int fq, PG8_LAS unsigned char* lds, int wid, int lane) const {
        PG8_LAS float* P = (PG8_LAS float*)lds;
        const int col0 = u.pn * BM + wc * 32 + 4 * fq;
#pragma unroll
        for (int ai = 0; ai < 2; ++ai)
#pragma unroll
            for (int m = 0; m < 4; ++m) { const int r = ai * HALF + wr * 64 + m * 16 + fr; const size_t off = (size_t)(u.pm * BM + r) * 1024 + col0; float s = 0.f;
#pragma unroll
                for (int bj = 0; bj < 2; ++bj)
#pragma unroll
                    for (int n = 0; n < 2; ++n) { const f32x4 o = acc[ai][bj][m][n];
                        if (out) *(f32x4*)(out + off + bj * HALF + n * 16) = o;
                        s += (o[0] * o[0] + o[1] * o[1]) + (o[2] * o[2] + o[3] * o[3]);
                        if (outb) { u32x2 w; w.x = cvtpk(o[0], o[1]); w.y = cvtpk(o[2], o[3]); *(u32x2*)(outb + off + bj * HALF + n * 16) = w; } }
                s += __shfl_xor(s, 16); s += __shfl_xor(s, 32);
                if (fq == 0) P[r * 4 + wc] = s; }
        __syncthreads();
        const int tid = wid * 64 + lane;
        if (tid < 256) { const float t = (P[tid * 4 + 0] + P[tid * 4 + 1]) + (P[tid * 4 + 2] + P[tid * 4 + 3]); ss[(size_t)(u.pm * BM + tid) * 4 + u.pn] = t; }
    }
};

struct EpiSwiglu {
    static constexpr bool PERM = true, AFTER_DRAIN = false;
    bf16_t* hid; const float* ss;
    __device__ __forceinline__ void operator()(const f32x4 (&acc)[2][2][4][2], const Unit& u, int wr, int wc, int fr, int fq) const {
        const int row0 = u.pm * BM + wr * 64 + fr, col0 = u.pn * HALF + wc * 32 + 8 * fq;
#pragma unroll
        for (int ai = 0; ai < 2; ++ai)
#pragma unroll
            for (int m = 0; m < 4; ++m) { const int row = row0 + ai * HALF + m * 16; const f32x4 s4 = *(const f32x4*)(ss + (size_t)row * 4);
                const float rstd = __builtin_amdgcn_rsqf(((s4[0] + s4[1]) + (s4[2] + s4[3])) * (1.0f / 1024.0f) + 1e-6f);
                float a[8];
#pragma unroll
                for (int n = 0; n < 2; ++n)
#pragma unroll
                    for (int e = 0; e < 4; ++e) { const float g = acc[ai][0][m][n][e] * rstd, up = acc[ai][1][m][n][e] * rstd; a[4 * n + e] = g * __builtin_amdgcn_rcpf(1.0f + __expf(-g)) * up; }
                u32x4 w; w.x = cvtpk(a[0], a[1]); w.y = cvtpk(a[2], a[3]); w.z = cvtpk(a[4], a[5]); w.w = cvtpk(a[6], a[7]);
                *(u32x4*)(hid + (size_t)row * 2816 + col0) = w; }
    }
};

struct EpiFinal {
    static constexpr bool PERM = false, AFTER_DRAIN = true;
    const bf16_t* base; float* out; float* ss; unsigned* cnt; const float* gf;
    __device__ __forceinline__ void init(f32x4 (&acc)[2][2][4][2], const Unit& u, int wr, int wc, int fr, int fq) const {
        const int col0 = u.pn * BM + wc * 32 + 4 * fq;
#pragma unroll
        for (int ai = 0; ai < 2; ++ai)
#pragma unroll
            for (int m = 0; m < 4; ++m) { const size_t off = (size_t)(u.pm * BM + ai * HALF + wr * 64 + m * 16 + fr) * 1024 + col0;
#pragma unroll
                for (int bj = 0; bj < 2; ++bj)
#pragma unroll
                    for (int n = 0; n < 2; ++n) { const u32x2 bw = __builtin_nontemporal_load((const u32x2*)(base + off + bj * HALF + n * 16));
                        acc[ai][bj][m][n] = (f32x4){__uint_as_float(bw.x << 16), __uint_as_float(bw.x & 0xffff0000u), __uint_as_float(bw.y << 16), __uint_as_float(bw.y & 0xffff0000u)}; } }
    }
    __device__ __forceinline__ void fused(f32x4 (&acc)[2][2][4][2], const Unit& u, int wr, int wc, int fr, int fq, PG8_LAS unsigned char* lds, int wid, int lane) const {
        PG8_LAS float* P = (PG8_LAS float*)lds;
        PG8_LAS float* S = (PG8_LAS float*)(lds + 4096);
        const int col0 = u.pn * BM + wc * 32 + 4 * fq;
#pragma unroll
        for (int ai = 0; ai < 2; ++ai)
#pragma unroll
            for (int m = 0; m < 4; ++m) { const int r = ai * HALF + wr * 64 + m * 16 + fr; float s = 0.f;
#pragma unroll
                for (int bj = 0; bj < 2; ++bj)
#pragma unroll
                    for (int n = 0; n < 2; ++n) { const f32x4 o = acc[ai][bj][m][n]; s += (o[0] * o[0] + o[1] * o[1]) + (o[2] * o[2] + o[3] * o[3]); }
                s += __shfl_xor(s, 16); s += __shfl_xor(s, 32);
                if (fq == 0) P[r * 4 + wc] = s; }
        __syncthreads();
        const int tid = wid * 64 + lane;
        float* slot = ss + (size_t)(u.pm * BM + (tid & 255)) * 4;
        if (tid < 256) { const float t = (P[tid * 4 + 0] + P[tid * 4 + 1]) + (P[tid * 4 + 2] + P[tid * 4 + 3]); __hip_atomic_store(slot + u.pn, t, __ATOMIC_RELAXED, __HIP_MEMORY_SCOPE_AGENT); }
        asm volatile("s_waitcnt vmcnt(0)" ::: "memory");
        unsigned* c = cnt + 64 * u.pm;
        if (lane == 0) __hip_atomic_fetch_add(c, 1u, __ATOMIC_RELAXED, __HIP_MEMORY_SCOPE_AGENT);
        if (wid == 0) {
            unsigned sp = 0;
            while ((unsigned)__builtin_amdgcn_readfirstlane(__hip_atomic_load(c, __ATOMIC_RELAXED, __HIP_MEMORY_SCOPE_AGENT)) < 32u) { __builtin_amdgcn_s_sleep(2); if (++sp > (1u << 22)) break; }
            __builtin_amdgcn_fence(__ATOMIC_ACQUIRE, "agent");
        }
        asm volatile("s_waitcnt vmcnt(0) lgkmcnt(0)" ::: "memory");
        __syncthreads();
        if (tid < 256) { float t4[4];
#pragma unroll
            for (int t = 0; t < 4; ++t) t4[t] = __hip_atomic_load(slot + t, __ATOMIC_RELAXED, __HIP_MEMORY_SCOPE_AGENT);
            S[tid] = 1.0f / sqrtf(((t4[0] + t4[1]) + (t4[2] + t4[3])) * (1.0f / 1024.0f) + 1e-6f); }
        __syncthreads();
#pragma unroll
        for (int ai = 0; ai < 2; ++ai)
#pragma unroll
            for (int m = 0; m < 4; ++m) { const int r = ai * HALF + wr * 64 + m * 16 + fr; const float rs = S[r]; const size_t off = (size_t)(u.pm * BM + r) * 1024 + col0;
#pragma unroll
                for (int bj = 0; bj < 2; ++bj)
#pragma unroll
                    for (int n = 0; n < 2; ++n) { const f32x4 g4 = *(const f32x4*)(gf + col0 + bj * HALF + n * 16); __builtin_nontemporal_store(acc[ai][bj][m][n] * rs * g4, (f32x4*)(out + off + bj * HALF + n * 16)); } }
    }
};
template <class Epi, class Sched, bool ALIGN_EPI = false, bool SP2 = false>
__device__ __forceinline__ void gemm_phase(PG8_LAS unsigned char* lds, const Gemm g, const Sched& S, const Epi& E) {
    int tid_ = threadIdx.x; asm volatile("" : "+v"(tid_));
    const int tid = tid_, wid = __builtin_amdgcn_readfirstlane(tid >> 6), lane = tid & 63, wr = wid >> 2, wc = wid & 3, fr = lane & 15, fq = lane >> 4;
    const int K = g.K, nt = K / BK;
    unsigned voffA[2], voffB[2];
#pragma unroll
    for (int i = 0; i < 2; ++i) { int R, C; stage_rc(tid * 16 + i * 8192, R, C); const int Rb = Epi::PERM ? ((R & ~31) + perm32(R & 31)) : R;
        voffA[i] = (unsigned)(R * K + C) * 2u; voffB[i] = (unsigned)(Rb * K + C) * 2u; }
    const size_t kstep = (size_t)(BK * 2);
    const size_t hstep = (size_t)HALF * K * 2;
    const size_t tstep = 2 * hstep;
    const unsigned ldsw = (unsigned)wid * 1024u;
    const int aoff = lds_byte(wr * 64 + fr, fq * 8), boff = lds_byte(wc * 32 + fr, fq * 8);
#define PG8_SA(b, h) (((b) * 2 + (h)) * HTB)
#define PG8_SB(b, h) ((4 + (b) * 2 + (h)) * HTB)
#define PG8_STAGE(bufoff, gbase, voff) do { _Pragma("unroll") for (int _i = 0; _i < 2; ++_i) \
        __builtin_amdgcn_global_load_lds((const unsigned*)((const char*)(gbase) + (voff)[_i]), (PG8_LAS unsigned*)(lds + (bufoff) + ldsw + _i * 8192), 16, 0, 0); } while (0)
#define PG8_LDA(dst, b, h) do { _Pragma("unroll") for (int m = 0; m < 4; ++m) _Pragma("unroll") for (int k = 0; k < 2; ++k) dst[m][k] = *(const PG8_LAS bf16x8*)(lds + PG8_SA(b, h) + aoff + m * 2048 + k * 1024); } while (0)
#define PG8_LDB(dst, b, h) do { _Pragma("unroll") for (int n = 0; n < 2; ++n) _Pragma("unroll") for (int k = 0; k < 2; ++k) dst[n][k] = *(const PG8_LAS bf16x8*)(lds + PG8_SB(b, h) + boff + n * 2048 + k * 1024); } while (0)
#define PG8_MMA(ai, bj, At, Bt) do { __builtin_amdgcn_s_setprio(1); _Pragma("unroll") for (int m = 0; m < 4; ++m) _Pragma("unroll") for (int n = 0; n < 2; ++n) _Pragma("unroll") for (int k = 0; k < 2; ++k) \
        acc[ai][bj][m][n] = __builtin_amdgcn_mfma_f32_16x16x32_bf16(Bt[n][k], At[m][k], acc[ai][bj][m][n], 0, 0, 0); __builtin_amdgcn_s_setprio(0); } while (0)
#define PG8_WAIT_V(n) asm volatile("s_waitcnt vmcnt(" #n ")" ::: "memory")
#define PG8_WAIT_L(n) asm volatile("s_waitcnt lgkmcnt(" #n ")" ::: "memory")
#define PG8_BAR __builtin_amdgcn_s_barrier()
#define PG8_SCHED __builtin_amdgcn_sched_barrier(0)
    Unit cur, nxt; int ui = 0;
    if (!S.next(0, cur)) return;
    f32x4 acc[2][2][4][2];
    if constexpr (Epi::AFTER_DRAIN) E.init(acc, cur, wr, wc, fr, fq);
    else {
#pragma unroll
    for (int a = 0; a < 2; ++a)
#pragma unroll
        for (int b = 0; b < 2; ++b)
#pragma unroll
            for (int m = 0; m < 4; ++m)
#pragma unroll
                for (int n = 0; n < 2; ++n) acc[a][b][m][n] = (f32x4){0.f, 0.f, 0.f, 0.f};
    }
    bf16x8 At[4][2], B0[2][2], B1[2][2];
    const char* cA = (const char*)g.A + (size_t)cur.pm * tstep; const char* cB = (const char*)g.Bt + (size_t)cur.pn * tstep;
    S.a_ready(cur);
    if constexpr (SP2) {
        PG8_STAGE(PG8_SB(0, 0), cB, voffB); PG8_STAGE(PG8_SB(0, 1), cB + hstep, voffB); PG8_STAGE(PG8_SA(0, 0), cA, voffA); PG8_STAGE(PG8_SA(0, 1), cA + hstep, voffA);
        if (wr == 1) PG8_BAR;
        PG8_WAIT_V(2); PG8_BAR;
        PG8_STAGE(PG8_SB(1, 0), cB + kstep, voffB); PG8_STAGE(PG8_SA(1, 0), cA + kstep, voffA); PG8_STAGE(PG8_SB(1, 1), cB + hstep + kstep, voffB);
        PG8_WAIT_V(6); PG8_BAR;
    } else {
        PG8_STAGE(PG8_SB(0, 0), cB, voffB); PG8_STAGE(PG8_SA(0, 0), cA, voffA); PG8_STAGE(PG8_SB(0, 1), cB + hstep, voffB); PG8_STAGE(PG8_SA(0, 1), cA + hstep, voffA);
        if (wr == 1) PG8_BAR;
        PG8_WAIT_V(4); PG8_BAR;
        PG8_STAGE(PG8_SB(1, 0), cB + kstep, voffB); PG8_STAGE(PG8_SA(1, 0), cA + kstep, voffA); PG8_STAGE(PG8_SB(1, 1), cB + hstep + kstep, voffB);
        PG8_WAIT_V(6); PG8_BAR;
    }
    for (;;) {
        const bool has_next = S.next(ui + 1, nxt);
        const char* nA = has_next ? (const char*)g.A + (size_t)nxt.pm * tstep : cA; const char* nB = has_next ? (const char*)g.Bt + (size_t)nxt.pn * tstep : cB;
        for (int t = 0; t < nt; t += 2) {
            const bool last = (t == nt - 2);
            const char* a1 = cA + (size_t)(t + 1) * kstep;
            const char* a2 = last ? nA : cA + (size_t)(t + 2) * kstep; const char* b2 = last ? nB : cB + (size_t)(t + 2) * kstep;
            const char* a3 = a2 + kstep; const char* b3 = b2 + kstep;
            if (last && has_next) S.a_ready(nxt);
            if constexpr (SP2) {
            PG8_LDB(B0, 0, 0); PG8_LDB(B1, 0, 1); PG8_SCHED; PG8_LDA(At, 0, 0); PG8_STAGE(PG8_SA(1, 1), a1 + hstep, voffA);
            PG8_WAIT_V(8); PG8_WAIT_L(0); PG8_BAR; PG8_MMA(0, 0, At, B0); PG8_MMA(0, 1, At, B1); PG8_BAR; PG8_SCHED;
            PG8_LDA(At, 0, 1); PG8_STAGE(PG8_SB(0, 0), b2, voffB); PG8_STAGE(PG8_SB(0, 1), b2 + hstep, voffB); PG8_STAGE(PG8_SA(0, 0), a2, voffA);
            PG8_WAIT_V(8); PG8_WAIT_L(0); PG8_BAR; PG8_MMA(1, 0, At, B0); PG8_MMA(1, 1, At, B1); PG8_BAR; PG8_SCHED;
            PG8_LDB(B0, 1, 0); PG8_LDB(B1, 1, 1); PG8_SCHED; PG8_LDA(At, 1, 0); PG8_STAGE(PG8_SA(0, 1), a2 + hstep, voffA);
            PG8_WAIT_V(8); PG8_WAIT_L(0); PG8_BAR; PG8_MMA(0, 0, At, B0); PG8_MMA(0, 1, At, B1); PG8_BAR; PG8_SCHED;
            PG8_LDA(At, 1, 1); PG8_STAGE(PG8_SB(1, 0), b3, voffB); PG8_STAGE(PG8_SB(1, 1), b3 + hstep, voffB); PG8_STAGE(PG8_SA(1, 0), a3, voffA);
            PG8_WAIT_V(8); PG8_WAIT_L(0); PG8_BAR; PG8_MMA(1, 0, At, B0); PG8_MMA(1, 1, At, B1); PG8_BAR; PG8_SCHED;
            } else {
            PG8_LDB(B0, 0, 0); PG8_SCHED; PG8_LDA(At, 0, 0); PG8_STAGE(PG8_SA(1, 1), a1 + hstep, voffA);
            PG8_WAIT_L(8); PG8_BAR; PG8_WAIT_L(0); PG8_MMA(0, 0, At, B0); PG8_BAR; PG8_SCHED;
            PG8_LDB(B1, 0, 1); PG8_STAGE(PG8_SB(0, 0), b2, voffB);
            PG8_BAR; PG8_WAIT_L(0); PG8_MMA(0, 1, At, B1); PG8_BAR;
            PG8_LDA(At, 0, 1); PG8_STAGE(PG8_SA(0, 0), a2, voffA);
            PG8_BAR; PG8_WAIT_L(0); PG8_MMA(1, 0, At, B0); PG8_BAR; PG8_SCHED;
            PG8_STAGE(PG8_SB(0, 1), b2 + hstep, voffB);
            PG8_WAIT_V(6); PG8_BAR; PG8_MMA(1, 1, At, B1); PG8_BAR;
            PG8_LDB(B0, 1, 0); PG8_SCHED; PG8_LDA(At, 1, 0); PG8_STAGE(PG8_SA(0, 1), a2 + hstep, voffA);
            PG8_WAIT_L(8); PG8_BAR; PG8_WAIT_L(0); PG8_MMA(0, 0, At, B0); PG8_BAR; PG8_SCHED;
            PG8_LDB(B1, 1, 1); PG8_STAGE(PG8_SB(1, 0), b3, voffB);
            PG8_BAR; PG8_WAIT_L(0); PG8_MMA(0, 1, At, B1); PG8_BAR;
            PG8_LDA(At, 1, 1); PG8_STAGE(PG8_SA(1, 0), a3, voffA);
            PG8_BAR; PG8_WAIT_L(0); PG8_MMA(1, 0, At, B0); PG8_BAR; PG8_SCHED;
            PG8_STAGE(PG8_SB(1, 1), b3 + hstep, voffB);
            PG8_WAIT_V(6); PG8_BAR; PG8_MMA(1, 1, At, B1); PG8_BAR;
            }
        }
        if constexpr (ALIGN_EPI) { if (wr == 0) PG8_BAR; }
        if constexpr (!Epi::AFTER_DRAIN) { E(acc, cur, wr, wc, fr, fq); S.done(cur); }
        if (!has_next) break;
#pragma unroll
        for (int a = 0; a < 2; ++a)
#pragma unroll
            for (int b = 0; b < 2; ++b)
#pragma unroll
                for (int m = 0; m < 4; ++m)
#pragma unroll
                    for (int n = 0; n < 2; ++n) acc[a][b][m][n] = (f32x4){0.f, 0.f, 0.f, 0.f};
        cur = nxt; cA = nA; cB = nB; ++ui;
        if constexpr (ALIGN_EPI) { if (wr == 1) PG8_BAR; }
    }
    PG8_WAIT_V(0);
    if constexpr (!ALIGN_EPI) { if (wr == 0) PG8_BAR; }
    PG8_BAR;
    if constexpr (Epi::AFTER_DRAIN) { E.fused(acc, cur, wr, wc, fr, fq, lds, wid, lane); S.done(cur); }
#undef PG8_SA
#undef PG8_SB
#undef PG8_STAGE
#undef PG8_LDA
#undef PG8_LDB
#undef PG8_MMA
#undef PG8_WAIT_V
#undef PG8_WAIT_L
#undef PG8_BAR
#undef PG8_SCHED
}
}

using pg8::bf16_t; using pg8::bf16x8; using pg8::f32x4; using pg8::u32x4; using pg8::u32x2; using pg8::cvtpk;
typedef float f32x16 __attribute__((ext_vector_type(16)));
constexpr int D = 1024, SEQ = 8192, LP = 8320, NB = 2, MP = NB * LP, MX = NB * SEQ, INW = 3584, PW = 3072, FF = 2816;
constexpr float EPS = 1e-6f;
constexpr size_t MiB = 1u << 20;
constexpr size_t WS_WIN = 1 * MiB, WS_WOUT = 8 * MiB, WS_WGU = 10 * MiB, WS_WDN = 21 * MiB;
constexpr size_t WS_U = 27 * MiB;
constexpr size_t WS_LOGF = 60 * MiB;
constexpr size_t WS_UT = 93 * MiB;
constexpr size_t WS_SPREV = 31 * MiB;
constexpr size_t WS_MIX = 110 * MiB;
constexpr size_t WS_SMALL = 142 * MiB;
constexpr size_t WS_PROJ = 144 * MiB;
constexpr int LDS_BYTES = 147456;
constexpr int NWG = 256;

__device__ __forceinline__ float bflo(unsigned w) { return __uint_as_float(w << 16); }
__device__ __forceinline__ float bfhi(unsigned w) { return __uint_as_float(w & 0xffff0000u); }
__device__ __forceinline__ float wave_sum(float v) {
#pragma unroll
    for (int o = 1; o < 64; o <<= 1) v += __shfl_xor(v, o);
    return v;
}
#define LDS_WAIT() asm volatile("s_waitcnt lgkmcnt(0)" ::: "memory")

struct TItem { const float* W; bf16_t* WT; const float* gk; int K, N, mode, item; };
__device__ __forceinline__ void t_load(const TItem& t, float (&wv)[32], int lane) {
    const int nblk = t.N / 32, kb = t.item / nblk, nb = t.item % nblk, k0 = 64 * kb, n0 = 32 * nb;
#pragma unroll
    for (int i = 0; i < 32; ++i) { const int kk = 2 * i + (lane >> 5); wv[i] = __builtin_nontemporal_load(t.W + (size_t)(k0 + kk) * t.N + n0 + (lane & 31)); }
}
__device__ __forceinline__ void t_finish(const TItem& t, const float (&wv)[32], float* scr, int lane) {
    const int nblk = t.N / 32, kb = t.item / nblk, nb = t.item % nblk, k0 = 64 * kb, n0 = 32 * nb;
#pragma unroll
    for (int i = 0; i < 32; ++i) { const int kk = 2 * i + (lane >> 5); float w = wv[i]; if (t.gk) w *= t.gk[k0 + kk]; scr[kk * 33 + (lane & 31)] = w; }
    LDS_WAIT();
    const int c = lane & 7;
#pragma unroll
    for (int j = 0; j < 4; ++j) { const int n = (lane >> 3) + 8 * j; const float* s = scr + (8 * c) * 33 + n;
        u32x4 o; o.x = cvtpk(s[0 * 33], s[1 * 33]); o.y = cvtpk(s[2 * 33], s[3 * 33]); o.z = cvtpk(s[4 * 33], s[5 * 33]); o.w = cvtpk(s[6 * 33], s[7 * 33]);
        const int nn = n0 + n; const int drow = (t.mode == 0) ? nn : (((nn >> 7) << 8) + (nn & 127) + (t.mode == 2 ? 128 : 0));
        *(u32x4*)(t.WT + (size_t)drow * t.K + k0 + 8 * c) = o; }
    LDS_WAIT();
}
template <class MK> __device__ __forceinline__ void t_run(int first, int end, int step, const MK& mk, float* scr, int lane) {
    if (first >= end) return;
    float wa[32], wb[32]; TItem cur = mk(first); t_load(cur, wa, lane);
    for (int it = first; it < end; it += step) {
        const int nx = it + step; TItem nxt = cur;
        if (nx < end) { nxt = mk(nx); t_load(nxt, wb, lane); }
        t_finish(cur, wa, scr, lane);
        cur = nxt;
#pragma unroll
        for (int i = 0; i < 32; ++i) wa[i] = wb[i];
    }
}
__device__ __forceinline__ void u_load4(int m0, const float* x, const float* meta, f32x4 (&v)[4][4], int lane) {
#pragma unroll
    for (int rr = 0; rr < 4; ++rr) { const int m = m0 + rr, b = m / LP, pos = m % LP;
        const float* src = pos < 112 ? nullptr : (pos < 128 ? meta + (size_t)(pos - 112) * D : x + ((size_t)b * SEQ + pos - 128) * D);
#pragma unroll
        for (int j = 0; j < 4; ++j) v[rr][j] = src ? __builtin_nontemporal_load((const f32x4*)src + lane + 64 * j) : (f32x4){0.f, 0.f, 0.f, 0.f}; }
}
__device__ __forceinline__ void u_finish4(int m0, const f32x4 (&v)[4][4], const float* g, bf16_t* U, int lane) {
    float s[4];
#pragma unroll
    for (int rr = 0; rr < 4; ++rr) { float t = 0.f;
#pragma unroll
        for (int j = 0; j < 4; ++j) t += (v[rr][j][0] * v[rr][j][0] + v[rr][j][1] * v[rr][j][1]) + (v[rr][j][2] * v[rr][j][2] + v[rr][j][3] * v[rr][j][3]);
        s[rr] = t; }
#pragma unroll
    for (int o = 1; o < 64; o <<= 1) {
#pragma unroll
        for (int rr = 0; rr < 4; ++rr) s[rr] += __shfl_xor(s[rr], o); }
#pragma unroll
    for (int rr = 0; rr < 4; ++rr) { const float rstd = __builtin_amdgcn_rsqf(s[rr] * (1.0f / D) + EPS); bf16_t* orow = U + (size_t)(m0 + rr) * D;
#pragma unroll
        for (int j = 0; j < 4; ++j) { const f32x4 g4 = ((const f32x4*)g)[lane + 64 * j]; const f32x4 o = v[rr][j] * rstd * g4;
            u32x2 w; w.x = cvtpk(o[0], o[1]); w.y = cvtpk(o[2], o[3]); ((u32x2*)orow)[lane + 64 * j] = w; } }
}

__device__ __forceinline__ void stage_vT(const bf16_t* PROJ, size_t m0, int h, bf16_t* vT) {
    const int tid = threadIdx.x;
#pragma unroll
    for (int ii = 0; ii < 2; ++ii) { const int it = tid + 512 * ii, sp = it & 63, vc = it >> 6;
        const bf16_t* src = PROJ + (m0 + 2 * sp) * PW + 2048 + h * 128 + vc * 8;
        const u32x4 d0 = *(const u32x4*)src, d1 = *(const u32x4*)(src + PW);
#pragma unroll
        for (int j = 0; j < 4; ++j) { *(unsigned*)(vT + (vc * 8 + 2 * j) * 136 + 2 * sp) = (d0[j] & 0xffffu) | (d1[j] << 16);
            *(unsigned*)(vT + (vc * 8 + 2 * j + 1) * 136 + 2 * sp) = (d0[j] >> 16) | (d1[j] & 0xffff0000u); } }
}
__device__ __forceinline__ f32x4 exp4(f32x4 v) { return (f32x4){__expf(v[0]), __expf(v[1]), __expf(v[2]), __expf(v[3])}; }
__device__ __forceinline__ void hg_local_unit(int unit, bool light, const float* LOGF, const bf16_t* PROJ, bf16_t* KH, bf16_t* QT, bf16_t* QB, float* DB, bf16_t* UT, float* DEC, unsigned char* lds) {
    const int tid = threadIdx.x, lane = tid & 63, w = __builtin_amdgcn_readfirstlane(tid >> 6);
    const int bh = unit / 65, c = unit % 65, b = bh >> 2, h = bh & 3;
    const size_t m0 = (size_t)b * LP + (size_t)c * 128;
    bf16_t* kT = (bf16_t*)lds;
    bf16_t* vT = (bf16_t*)(lds + 34816);
    float* tot = (float*)(lds + 69632);
    const int kq = tid & 31, rg = tid >> 5;
    if (!light) stage_vT(PROJ, m0, h, vT);
    const size_t rbase = (m0 + rg * 8) * 512 + h * 128 + 4 * kq;
    f32x4 pre[8], kk[8]; u32x2 qw[8]; f32x4 run = (f32x4){0.f, 0.f, 0.f, 0.f};
#pragma unroll
    for (int i = 0; i < 8; ++i) pre[i] = __builtin_nontemporal_load((const f32x4*)(LOGF + rbase + (size_t)i * 512));
#pragma unroll
    for (int i = 0; i < 8; ++i) qw[i] = *(const u32x2*)(PROJ + (m0 + rg * 8 + i) * PW + 1536 + h * 128 + 4 * kq);
#pragma unroll
    for (int i = 0; i < 8; ++i) { const f32x4 lf = pre[i]; run += lf; pre[i] = run; kk[i] = 1.0f - exp4(lf); }
    *(f32x4*)(tot + rg * 128 + 4 * kq) = run;
    __syncthreads();
    f32x4 off = (f32x4){0.f, 0.f, 0.f, 0.f}, Bj = off, blast = off; const int g0 = rg & ~1;
#pragma unroll
    for (int g = 0; g < 16; ++g) { const f32x4 t = *(const f32x4*)(tot + g * 128 + 4 * kq); if (g < rg) off += t; if (g < g0) Bj += t; blast += t; }
    const f32x4 Ej = Bj + *(const f32x4*)(tot + g0 * 128 + 4 * kq) + *(const f32x4*)(tot + (g0 + 1) * 128 + 4 * kq);
    const f32x4 cE = exp4(blast - Ej);
    u32x4 ktw[4];
#pragma unroll
    for (int i = 0; i < 8; i += 2) {
        const f32x4 b0 = off + pre[i], b1 = off + pre[i + 1];
        const f32x4 kh0 = kk[i] * exp4(Ej - b0), kh1 = kk[i + 1] * exp4(Ej - b1);
        const f32x4 q0 = (f32x4){bflo(qw[i].x), bfhi(qw[i].x), bflo(qw[i].y), bfhi(qw[i].y)}, q1 = (f32x4){bflo(qw[i + 1].x), bfhi(qw[i + 1].x), bflo(qw[i + 1].y), bfhi(qw[i + 1].y)};
        const f32x4 qt0 = q0 * exp4(b0 - Bj), qt1 = q1 * exp4(b1 - Bj), qb0 = q0 * exp4(b0), qb1 = q1 * exp4(b1);
        u32x2 s;
        s.x = cvtpk(kh0[0], kh0[1]); s.y = cvtpk(kh0[2], kh0[3]); *(u32x2*)(KH + rbase + (size_t)i * 512) = s;
        s.x = cvtpk(kh1[0], kh1[1]); s.y = cvtpk(kh1[2], kh1[3]); *(u32x2*)(KH + rbase + (size_t)(i + 1) * 512) = s;
        s.x = cvtpk(qt0[0], qt0[1]); s.y = cvtpk(qt0[2], qt0[3]); *(u32x2*)(QT + rbase + (size_t)i * 512) = s;
        s.x = cvtpk(qt1[0], qt1[1]); s.y = cvtpk(qt1[2], qt1[3]); *(u32x2*)(QT + rbase + (size_t)(i + 1) * 512) = s;
        s.x = cvtpk(qb0[0], qb0[1]); s.y = cvtpk(qb0[2], qb0[3]); *(u32x2*)(QB + rbase + (size_t)i * 512) = s;
        s.x = cvtpk(qb1[0], qb1[1]); s.y = cvtpk(qb1[2], qb1[3]); *(u32x2*)(QB + rbase + (size_t)(i + 1) * 512) = s;
        const f32x4 u0 = kh0 * cE, u1 = kh1 * cE;
#pragma unroll
        for (int cc = 0; cc < 4; ++cc) ktw[cc][i >> 1] = cvtpk(u0[cc], u1[cc]);
    }
#pragma unroll
    for (int cc = 0; cc < 4; ++cc) *(u32x4*)(kT + (4 * kq + cc) * 136 + rg * 8) = ktw[cc];
    if ((rg & 1) == 0) *(f32x4*)(DB + (size_t)unit * 1024 + (rg >> 1) * 128 + 4 * kq) = exp4(Ej - Bj);
    if (rg == 0) *(f32x4*)(DEC + unit * 128 + 4 * kq) = exp4(blast);
    __syncthreads();
    if (light) return;
    const int r = lane & 15, quad = lane >> 4;
    f32x4 acc[8];
#pragma unroll
    for (int vt = 0; vt < 8; ++vt) acc[vt] = (f32x4){0.f, 0.f, 0.f, 0.f};
#pragma unroll
    for (int ss = 0; ss < 4; ++ss) { const bf16x8 a = *(const bf16x8*)(kT + (16 * w + r) * 136 + 32 * ss + quad * 8);
#pragma unroll
        for (int vt = 0; vt < 8; ++vt) { const bf16x8 bb = *(const bf16x8*)(vT + (16 * vt + r) * 136 + 32 * ss + quad * 8); acc[vt] = __builtin_amdgcn_mfma_f32_16x16x32_bf16(a, bb, acc[vt], 0, 0, 0); } }
#pragma unroll
    for (int vt = 0; vt < 8; ++vt) { u32x2 o; o.x = cvtpk(acc[vt][0], acc[vt][1]); o.y = cvtpk(acc[vt][2], acc[vt][3]);
        *(u32x2*)(UT + (size_t)unit * 16384 + (16 * vt + r) * 128 + 16 * w + quad * 4) = o; }
    __syncthreads();
}

__device__ __forceinline__ void attn_unit(int au, const bf16_t* PROJ, const float* sbn, bf16_t* MIX, bf16_t* vl) {
    const int lane = threadIdx.x & 63, r32 = lane & 31, hh = lane >> 5;
    const int qt = au & 255, head = (au >> 8) & 7, b = au >> 11;
    const int q0 = 128 + 32 * qt; const size_t mb = (size_t)b * LP;
    const bf16_t* Qp = PROJ + (mb + q0 + r32) * PW + head * 64 + 8 * hh;
    bf16x8 qf[4];
#pragma unroll
    for (int ds = 0; ds < 4; ++ds) qf[ds] = *(const bf16x8*)(Qp + 16 * ds);
    f32x16 o0, o1;
#pragma unroll
    for (int i = 0; i < 16; ++i) { o0[i] = 0.f; o1[i] = 0.f; }
    float carry = 0.f; const int qpos = q0 + r32;
    const int vpr = lane & 15, vch = lane >> 4;
    const bf16_t* Kbase = PROJ + (mb + r32) * PW + 512 + head * 64 + 8 * hh;
    const bf16_t* Vbase = PROJ + (mb + 2 * vpr) * PW + 1024 + head * 64 + vch * 8;
    int kt = q0 >> 5;
    bf16x8 kn[4]; u32x4 vn[4];
#pragma unroll
    for (int ds = 0; ds < 4; ++ds) kn[ds] = *(const bf16x8*)(Kbase + (size_t)(32 * kt) * PW + 16 * ds);
#pragma unroll
    for (int i = 0; i < 4; ++i) vn[i] = *(const u32x4*)(Vbase + (size_t)(32 * kt + (i & 1)) * PW + 32 * (i >> 1));
    for (;;) {
        const int kv0 = 32 * kt; const bool more = kt > 3;
        bf16x8 kf[4];
#pragma unroll
        for (int ds = 0; ds < 4; ++ds) kf[ds] = kn[ds];
#pragma unroll
        for (int i = 0; i < 2; ++i)
#pragma unroll
            for (int m = 0; m < 4; ++m) { const unsigned d0 = vn[2 * i][m], d1 = vn[2 * i + 1][m]; const int dd = (vch + 4 * i) * 8 + 2 * m;
                *(unsigned*)(vl + dd * 36 + 2 * vpr) = __builtin_amdgcn_perm(d1, d0, 0x05040100u); *(unsigned*)(vl + (dd + 1) * 36 + 2 * vpr) = __builtin_amdgcn_perm(d1, d0, 0x07060302u); }
        asm volatile("" ::: "memory");
        if (more) {
#pragma unroll
            for (int ds = 0; ds < 4; ++ds) kn[ds] = *(const bf16x8*)(Kbase + (size_t)(kv0 - 32) * PW + 16 * ds);
#pragma unroll
            for (int i = 0; i < 4; ++i) vn[i] = *(const u32x4*)(Vbase + (size_t)(kv0 - 32 + (i & 1)) * PW + 32 * (i >> 1));
        }
        f32x16 x;
#pragma unroll
        for (int i = 0; i < 16; ++i) x[i] = 0.f;
#pragma unroll
        for (int ds = 0; ds < 4; ++ds) x = __builtin_amdgcn_mfma_f32_32x32x16_bf16(kf[ds], qf[ds], x, 0, 0, 0);
        float be[16], om[16];
        const bool edge = (kt == (q0 >> 5)) || (kt == 3);
#pragma unroll
        for (int i = 0; i < 16; ++i) { const float zp = x[i]; const float u = __builtin_amdgcn_exp2f(-fabsf(zp)); const float s = __builtin_amdgcn_rcpf(1.0f + u), us = u * s;
            be[i] = zp > 0.f ? s : us; om[i] = zp > 0.f ? us : s; }
        if (edge) {
#pragma unroll
            for (int i = 0; i < 16; ++i) { const int kv = kv0 + (i & 3) + 8 * (i >> 2) + 4 * hh; const bool vis = (kv < qpos) && (kv >= 112); be[i] = vis ? be[i] : 0.f; om[i] = vis ? om[i] : 1.0f; } }
        float gp[4], pp[4], T[4]; float run = 1.0f;
#pragma unroll
        for (int g = 0; g < 4; ++g) gp[g] = (om[4 * g] * om[4 * g + 1]) * (om[4 * g + 2] * om[4 * g + 3]);
#pragma unroll
        for (int g = 0; g < 4; ++g) pp[g] = __shfl_xor(gp[g], 32);
#pragma unroll
        for (int g = 3; g >= 0; --g) { T[g] = hh == 0 ? run * pp[g] : run; run *= gp[g] * pp[g]; }
        const float C = __builtin_amdgcn_exp2f(carry);
        float wv[16];
#pragma unroll
        for (int g = 0; g < 4; ++g) { float a = C * T[g];
#pragma unroll
            for (int e = 3; e >= 0; --e) { const int i = 4 * g + e; wv[i] = be[i] * a; a *= om[i]; } }
        carry += __builtin_amdgcn_logf(run);
        bf16x8 xs[2];
#pragma unroll
        for (int s = 0; s < 2; ++s) { u32x4 pw; pw.x = cvtpk(wv[8 * s], wv[8 * s + 1]); pw.y = cvtpk(wv[8 * s + 2], wv[8 * s + 3]); pw.z = cvtpk(wv[8 * s + 4], wv[8 * s + 5]); pw.w = cvtpk(wv[8 * s + 6], wv[8 * s + 7]);
            xs[s] = __builtin_bit_cast(bf16x8, pw); }
        const bf16_t* vp = vl + r32 * 36 + 4 * hh;
#pragma unroll
        for (int s = 0; s < 2; ++s) {
            const u32x2 a0 = *(const u32x2*)(vp + 16 * s), a1 = *(const u32x2*)(vp + 16 * s + 8), b0 = *(const u32x2*)(vp + 32 * 36 + 16 * s), b1 = *(const u32x2*)(vp + 32 * 36 + 16 * s + 8);
            u32x4 wa, wb; wa.x = a0.x; wa.y = a0.y; wa.z = a1.x; wa.w = a1.y; wb.x = b0.x; wb.y = b0.y; wb.z = b1.x; wb.w = b1.y;
            const bf16x8 va = __builtin_bit_cast(bf16x8, wa), vb = __builtin_bit_cast(bf16x8, wb);
            o0 = __builtin_amdgcn_mfma_f32_32x32x16_bf16(va, xs[s], o0, 0, 0, 0);
            o1 = __builtin_amdgcn_mfma_f32_32x32x16_bf16(vb, xs[s], o1, 0, 0, 0);
        }
        asm volatile("" ::: "memory");
        if (!more || __all(carry < -152.0f)) break;
        --kt;
    }
    float ss = 0.f;
#pragma unroll
    for (int i = 0; i < 16; ++i) ss += o0[i] * o0[i] + o1[i] * o1[i];
    ss += __shfl_xor(ss, 32);
    const float rstd = 1.0f / sqrtf(ss * (1.0f / 64.0f) + EPS);
    bf16_t* orow = MIX + ((size_t)b * SEQ + q0 - 128 + r32) * D + head * 64;
#pragma unroll
    for (int g = 0; g < 4; ++g) { const int d0 = 8 * g + 4 * hh;
        const f32x4 g0 = *(const f32x4*)(sbn + head * 64 + d0), g1 = *(const f32x4*)(sbn + head * 64 + 32 + d0);
        u32x2 w0, w1;
        w0.x = cvtpk(o0[4 * g] * rstd * g0[0], o0[4 * g + 1] * rstd * g0[1]); w0.y = cvtpk(o0[4 * g + 2] * rstd * g0[2], o0[4 * g + 3] * rstd * g0[3]);
        w1.x = cvtpk(o1[4 * g] * rstd * g1[0], o1[4 * g + 1] * rstd * g1[1]); w1.y = cvtpk(o1[4 * g + 2] * rstd * g1[2], o1[4 * g + 3] * rstd * g1[3]);
        *(u32x2*)(orow + d0) = w0; *(u32x2*)(orow + 32 + d0) = w1; }
}

__device__ __forceinline__ void hg_out_stage(int bh, int c, const bf16_t* PROJ, const bf16_t* UT, unsigned char* lds) {
    const int tid = threadIdx.x; const int b = bh >> 2, h = bh & 3, unit = bh * 65 + c;
    const size_t m0 = (size_t)b * LP + (size_t)c * 128;
    stage_vT(PROJ, m0, h, (bf16_t*)lds);
    bf16_t* sT = (bf16_t*)(lds + 34816);
#pragma unroll
    for (int ii = 0; ii < 4; ++ii) { const int p = tid + 512 * ii, s = p >> 4, vc = p & 15;
        const u32x4 e = *(const u32x4*)(UT + (size_t)unit * 16384 + s * 128 + vc * 8); *(u32x4*)(sT + s * 136 + vc * 8) = e; }
}
__device__ __forceinline__ void hg_out_wave(int bh, int c, int i, const bf16_t* KH, const bf16_t* QT, const bf16_t* QB, const float* DB, const bf16_t* PROJ, const float* hgn, bf16_t* MIX, const unsigned char* lds) {
    const int lane = threadIdx.x & 63, r = lane & 15, quad = lane >> 4;
    const int b = bh >> 2, h = bh & 3, unit = bh * 65 + c;
    const size_t m0 = (size_t)b * LP + (size_t)c * 128;
    const bf16_t* vT = (const bf16_t*)lds; const bf16_t* sT = (const bf16_t*)(lds + 34816);
    const size_t mt = m0 + 16 * i + r; const int kc = h * 128 + quad * 8;
    const bf16_t* KHl = KH + (m0 + r) * 512 + kc;
    const float* DBl = DB + (size_t)unit * 1024 + quad * 8;
    bf16x8 qtl[4], qbr[4]; float g[4][8]; u32x4 khn[4]; f32x4 dn[4][2];
#pragma unroll
    for (int ks = 0; ks < 4; ++ks) { qtl[ks] = *(const bf16x8*)(QT + mt * 512 + kc + 32 * ks); qbr[ks] = *(const bf16x8*)(QB + mt * 512 + kc + 32 * ks);
        khn[ks] = *(const u32x4*)(KHl + (size_t)(16 * i) * 512 + 32 * ks);
        const float* dp = DBl + i * 128 + 32 * ks; dn[ks][0] = *(const f32x4*)dp; dn[ks][1] = *(const f32x4*)(dp + 4); }
    f32x4 o[8];
#pragma unroll
    for (int vt = 0; vt < 8; ++vt) o[vt] = (f32x4){0.f, 0.f, 0.f, 0.f};
    f32x4 scA = (f32x4){0.f, 0.f, 0.f, 0.f}, scB = scA; int jA = i;
    for (int jb = i; jb >= 0; --jb) {
        const int mode = (jb == i) ? 0 : ((jb == i - 1) ? 1 : 2);
        u32x4 kh[4];
#pragma unroll
        for (int ks = 0; ks < 4; ++ks) { kh[ks] = khn[ks];
            if (mode == 0) {
#pragma unroll
                for (int j = 0; j < 4; ++j) { g[ks][j] = __builtin_amdgcn_rcpf(fmaxf(dn[ks][0][j], 1e-30f)); g[ks][4 + j] = __builtin_amdgcn_rcpf(fmaxf(dn[ks][1][j], 1e-30f)); } }
            else if (mode == 2) {
#pragma unroll
                for (int j = 0; j < 4; ++j) { g[ks][j] *= dn[ks][0][j]; g[ks][4 + j] *= dn[ks][1][j]; } } }
        if (jb > 0) {
#pragma unroll
            for (int ks = 0; ks < 4; ++ks) { khn[ks] = *(const u32x4*)(KHl + (size_t)(16 * (jb - 1)) * 512 + 32 * ks);
                const float* dp = DBl + jb * 128 + 32 * ks; dn[ks][0] = *(const f32x4*)dp; dn[ks][1] = *(const f32x4*)(dp + 4); } }
        f32x4 sc = (f32x4){0.f, 0.f, 0.f, 0.f};
#pragma unroll
        for (int ks = 0; ks < 4; ++ks) { u32x4 t = kh[ks];
            if (mode != 1) {
#pragma unroll
                for (int j = 0; j < 4; ++j) t[j] = cvtpk(bflo(kh[ks][j]) * g[ks][2 * j], bfhi(kh[ks][j]) * g[ks][2 * j + 1]); }
            sc = __builtin_amdgcn_mfma_f32_16x16x32_bf16(__builtin_bit_cast(bf16x8, t), qtl[ks], sc, 0, 0, 0); }
        if (mode == 0) {
#pragma unroll
            for (int jj = 0; jj < 4; ++jj) if (quad * 4 + jj > r) sc[jj] = 0.f;
#pragma unroll
            for (int ks = 0; ks < 4; ++ks)
#pragma unroll
                for (int j = 0; j < 8; ++j) g[ks][j] = 1.0f; }
        const bool second = ((i - jb) & 1) != 0;
        if (!second) { scA = sc; jA = jb; scB = (f32x4){0.f, 0.f, 0.f, 0.f}; } else scB = sc;
        if (second || jb == 0) {
            u32x4 pp; pp.x = cvtpk(scA[0], scA[1]); pp.y = cvtpk(scA[2], scA[3]); pp.z = cvtpk(scB[0], scB[1]); pp.w = cvtpk(scB[2], scB[3]);
            const bf16x8 pf = __builtin_bit_cast(bf16x8, pp);
            const int cA = 16 * jA + quad * 4, cB = 16 * jb + quad * 4;
#pragma unroll
            for (int vt = 0; vt < 8; ++vt) { const bf16_t* vp = vT + (16 * vt + r) * 136;
                const u32x2 a0 = *(const u32x2*)(vp + cA), a1 = *(const u32x2*)(vp + cB); u32x4 av; av.x = a0.x; av.y = a0.y; av.z = a1.x; av.w = a1.y;
                o[vt] = __builtin_amdgcn_mfma_f32_16x16x32_bf16(__builtin_bit_cast(bf16x8, av), pf, o[vt], 0, 0, 0); }
        }
    }
#pragma unroll
    for (int ks = 0; ks < 4; ++ks)
#pragma unroll
        for (int vt = 0; vt < 8; ++vt) { const bf16x8 sf = *(const bf16x8*)(sT + (16 * vt + r) * 136 + 32 * ks + quad * 8); o[vt] = __builtin_amdgcn_mfma_f32_16x16x32_bf16(sf, qbr[ks], o[vt], 0, 0, 0); }
    float ss = 0.f;
#pragma unroll
    for (int vt = 0; vt < 8; ++vt) ss += (o[vt][0] * o[vt][0] + o[vt][1] * o[vt][1]) + (o[vt][2] * o[vt][2] + o[vt][3] * o[vt][3]);
    ss += __shfl_xor(ss, 16); ss += __shfl_xor(ss, 32);
    const float rstd = __builtin_amdgcn_rsqf(ss * (1.0f / 128.0f) + EPS);
    const bf16_t* gp = PROJ + mt * PW + 2560 + h * 128 + quad * 4;
    bf16_t* op = MIX + ((size_t)b * SEQ + (size_t)c * 128 - 128 + 16 * i + r) * D + 512 + h * 128 + quad * 4;
#pragma unroll
    for (int vt = 0; vt < 8; ++vt) { const u32x2 gw = *(const u32x2*)(gp + 16 * vt); const f32x4 gn = *(const f32x4*)(hgn + h * 128 + 16 * vt + quad * 4);
        const float g0 = bflo(gw.x), g1 = bfhi(gw.x), g2 = bflo(gw.y), g3 = bfhi(gw.y);
        u32x2 ow; ow.x = cvtpk(o[vt][0] * rstd * gn[0] * (g0 * __builtin_amdgcn_rcpf(1.0f + __expf(-g0))), o[vt][1] * rstd * gn[1] * (g1 * __builtin_amdgcn_rcpf(1.0f + __expf(-g1))));
        ow.y = cvtpk(o[vt][2] * rstd * gn[2] * (g2 * __builtin_amdgcn_rcpf(1.0f + __expf(-g2))), o[vt][3] * rstd * gn[3] * (g3 * __builtin_amdgcn_rcpf(1.0f + __expf(-g3))));
        *(u32x2*)(op + 16 * vt) = ow; }
}

#define LAS __attribute__((address_space(3)))
#define XB_TMO      128
#define XB_XCNT(j)  (256  + 64 * (j))
#define XB_XSUB(j)  (1280 + 64 * (j))
#define XB_XGEN(j)  (2304 + 64 * (j))
#define XB_TOP      3328
#define XB_TOPGEN   3392
#define XCD_BAR_WORDS 3456
#define XB_SPIN_CAP (1u << 18)

__device__ __forceinline__ unsigned xb_ld(unsigned* p)              { return __hip_atomic_load(p, __ATOMIC_RELAXED, __HIP_MEMORY_SCOPE_AGENT); }
__device__ __forceinline__ unsigned xb_add(unsigned* p, unsigned v) { return __hip_atomic_fetch_add(p, v, __ATOMIC_RELAXED, __HIP_MEMORY_SCOPE_AGENT); }
__device__ __forceinline__ unsigned xb_xcc_id() { return (unsigned)__builtin_amdgcn_s_getreg((3 << 11) | 20) & 0xFu; }
#define XB_SPIN(cond, bar) do { unsigned _sp = 0; while (cond) { __builtin_amdgcn_s_sleep(1); \
    if ((++_sp & 255u) == 0u) { if (xb_ld(&(bar)[XB_TMO])) break; if (_sp > XB_SPIN_CAP) { atomicAdd(&(bar)[XB_TMO], 1u); break; } } } } while (0)

struct XcdBarrier {
    unsigned* bar; unsigned x;
    volatile LAS unsigned* st;
};

__device__ __forceinline__ XcdBarrier xcd_barrier_post(unsigned* bar, volatile LAS unsigned* st) {
    XcdBarrier b; b.bar = bar; b.x = xb_xcc_id(); b.st = st;
    if (threadIdx.x == 0) (void)xb_add(&bar[XB_XCNT(b.x)], 1u);
    return b;
}
__device__ __forceinline__ void xcd_barrier_complete(unsigned* bar, unsigned x, unsigned& nloc, unsigned& nx) {
    const unsigned G = gridDim.x * gridDim.y * gridDim.z;
    unsigned sum, cnt, mine, sp = 0u;
    for (;;) {
        sum = 0u; cnt = 0u; mine = 0u;
#pragma unroll
        for (unsigned j = 0; j < 16; ++j) { const unsigned c = xb_ld(&bar[XB_XCNT(j)]); sum += c; cnt += (c > 0u) ? 1u : 0u; mine = (j == x) ? c : mine; }
        if (sum == G) break;
        __builtin_amdgcn_s_sleep(1);
        if ((++sp & 255u) == 0u) { if (xb_ld(&bar[XB_TMO])) break; if (sp > XB_SPIN_CAP) { atomicAdd(&bar[XB_TMO], 1u); break; } }
    }
    nloc = mine > 0u ? mine : 1u; nx = cnt > 0u ? cnt : 1u;
}

__device__ __forceinline__ void xcd_barrier(const XcdBarrier& b) {
    asm volatile("s_waitcnt vmcnt(0)" ::: "memory");
    __syncthreads();
    if (threadIdx.x == 0) {
        unsigned* bar = b.bar;
        __builtin_amdgcn_s_waitcnt(0);
        unsigned nloc = b.st[0], nx = b.st[1];
        if (nloc == 0u) { xcd_barrier_complete(bar, b.x, nloc, nx); b.st[0] = nloc; b.st[1] = nx; }
        const unsigned old = xb_add(&bar[XB_XSUB(b.x)], 1u);
        const unsigned gen = old / nloc;
        if (old + 1u == (gen + 1u) * nloc) {
            __builtin_amdgcn_fence(__ATOMIC_RELEASE, "agent");
            asm volatile("s_waitcnt vmcnt(0)" ::: "memory");
            const unsigned og = xb_add(&bar[XB_TOP], 1u);
            const unsigned tg = og / nx;
            if (og + 1u == (tg + 1u) * nx) xb_add(&bar[XB_TOPGEN], 1u);
            else XB_SPIN(xb_ld(&bar[XB_TOPGEN]) == tg, bar);
            __builtin_amdgcn_fence(__ATOMIC_ACQUIRE, "agent");
            xb_add(&bar[XB_XGEN(b.x)], 1u);
            asm volatile("s_waitcnt vmcnt(0)" ::: "memory");
        } else {
            XB_SPIN(xb_ld(&bar[XB_XGEN(b.x)]) == gen, bar);
            __builtin_amdgcn_fence(__ATOMIC_ACQUIRE, "agent");
            asm volatile("s_waitcnt vmcnt(0)" ::: "memory");
        }
    }
    __syncthreads();
}

#ifndef PROBE_PHASE
#define PROBE_PHASE -1
#endif
#define PHT0(k) unsigned long long pt0_ = 0; if (PROBE_PHASE == (k)) pt0_ = __builtin_amdgcn_s_memrealtime()
#define PHT1(k) do { if (PROBE_PHASE == (k)) { const unsigned long long pt1_ = __builtin_amdgcn_s_memrealtime(), pd_ = pt1_ - pt0_; while (__builtin_amdgcn_s_memrealtime() - pt1_ < pd_) __builtin_amdgcn_s_sleep(8); } } while (0)
#ifndef REP_HL
#define REP_HL 1
#endif
#ifndef REP_AT
#define REP_AT 1
#endif
#ifndef REP_P2C
#define REP_P2C 1
#endif
#ifndef REP_SYNC
#define REP_SYNC 1
#endif
#ifndef REP_P0
#define REP_P0 1
#endif
#ifndef REP_P3
#define REP_P3 1
#endif
#ifndef REP_P5
#define REP_P5 1
#endif
#ifndef REP_P2B
#define REP_P2B 1
#endif
#ifndef REP_P1
#define REP_P1 1
#endif
#ifndef REP_P4
#define REP_P4 1
#endif
#define GSYNC() do { for (int rs_ = 0; rs_ < REP_SYNC; ++rs_) xcd_barrier(xbar); } while (0)
struct Args { const float* in[13]; float* out; unsigned char* ws; long long pad; };
__global__ void __launch_bounds__(512, 2) hybrid_fwd(Args a) {
    extern __shared__ __attribute__((aligned(16))) unsigned char lds[];
    cg::grid_group grid = cg::this_grid();
    const int tid = threadIdx.x, lane = tid & 63, wave = __builtin_amdgcn_readfirstlane(tid >> 6);
    const int G = gridDim.x, bx = blockIdx.x;
    typedef const __attribute__((address_space(4))) unsigned char* kptr_t;
    kptr_t kp = (kptr_t)__builtin_amdgcn_kernarg_segment_ptr();
#define KIN(i) (*(const float* const __attribute__((address_space(4)))*)(kp + 8 * (i)))
#define PH_BEGIN() asm volatile("" : "+s"(kp)); unsigned char* const ws = *(unsigned char* const __attribute__((address_space(4)))*)(kp + 112)
#define W_BF(off) ((bf16_t*)(ws + (off)))
#define W_F32(off) ((float*)(ws + (off)))
    volatile LAS unsigned* bst = (volatile LAS unsigned*)((LAS unsigned char*)lds + LDS_BYTES - 64);
    if (tid == 0) { bst[0] = 0u; bst[1] = 0u; }
    __syncthreads();
    const XcdBarrier xbar = xcd_barrier_post((unsigned*)a.ws, bst);
    PG8_LAS unsigned char* ldsp = (PG8_LAS unsigned char*)lds;

    { PHT0(0);
    {
        PH_BEGIN(); const float *x = KIN(0), *meta = KIN(1), *n1g = KIN(2), *w_in = KIN(3);
        bf16_t *Win_t = W_BF(WS_WIN), *U = W_BF(WS_U);
        float* scr = (float*)(lds + wave * 16384);
        const int gw = bx * 8 + wave, NGW = G * 8;
        constexpr int I_IN = (D / 64) * (INW / 32);
        constexpr int NGRP = MP / 4;
        f32x4 va[4][4], vb[4][4]; const int g0 = gw, g1 = gw + NGW, g2 = gw + 2 * NGW;
        if (g0 < NGRP) u_load4(4 * g0, x, meta, va, lane);
        if (g1 < NGRP) u_load4(4 * g1, x, meta, vb, lane);
        if (g0 < NGRP) u_finish4(4 * g0, va, n1g, U, lane);
        if (g1 < NGRP) u_finish4(4 * g1, vb, n1g, U, lane);
        for (int g = g2; g < NGRP; g += NGW) { u_load4(4 * g, x, meta, va, lane); u_finish4(4 * g, va, n1g, U, lane); }
        t_run(gw, I_IN, NGW, [&](int it) { return TItem{w_in, Win_t, nullptr, D, INW, 0, it}; }, scr, lane);
    }
    if (a.pad != 0) grid.sync();
    GSYNC(); PHT1(0); }
    { PHT0(1);
    {
        PH_BEGIN(); const float* lbl = KIN(6); bf16_t *U = W_BF(WS_U), *Win_t = W_BF(WS_WIN), *PROJ = W_BF(WS_PROJ); float* LOGF = W_F32(WS_LOGF);
        pg8::Gemm g{U, Win_t, MP, INW, D}; pg8::StaticOrder S; S.init(MP, INW, G, bx); S.rep = REP_P1;
        pg8::EpiProj E{PROJ, LOGF, lbl};
        pg8::gemm_phase<pg8::EpiProj, pg8::StaticOrder, true, true>(ldsp, g, S, E);
    }
    GSYNC(); PHT1(1); }
    { PHT0(2);
    {
        PH_BEGIN(); const float* sbn = KIN(4); bf16_t *PROJ = W_BF(WS_PROJ), *UT = W_BF(WS_UT), *MIX = W_BF(WS_MIX); float *LOGF = W_F32(WS_LOGF), *DB = W_F32(WS_U), *DEC = W_F32(WS_SMALL);
        bf16_t* KH = *(bf16_t* const __attribute__((address_space(4)))*)(kp + 104); bf16_t *QT = KH + (size_t)MP * 512, *QB = KH + (size_t)MP * 1024;
        for (int uu = bx; uu < 512 * REP_HL; uu += G) hg_local_unit(((uu >> 6) & 7) * 65 + (uu & 63), false, LOGF, PROJ, KH, QT, QB, DB, UT, DEC, lds);
        for (int uu = bx; uu < 8; uu += G) hg_local_unit(uu * 65 + 64, true, LOGF, PROJ, KH, QT, QB, DB, UT, DEC, lds);
        const int vcu = (G % 8 == 0) ? (bx % 8) * (G / 8) + bx / 8 : bx;
        for (int au = vcu * 8 + wave; au < 4096 * REP_AT; au += G * 8) attn_unit(au & 4095, PROJ, sbn, MIX, (bf16_t*)(lds + 73728 + wave * 4608));
    }
    GSYNC(); PHT1(2); }
    { PHT0(3);
    {
        PH_BEGIN(); const bf16_t* __restrict__ UT = W_BF(WS_UT); bf16_t* __restrict__ SP = W_BF(WS_SPREV); const float* __restrict__ DEC = W_F32(WS_SMALL);
        for (int rb = 0; rb < REP_P2B; ++rb) {
        const int gid = bx * 512 + tid;
        if (gid < 65536) { const int bh = gid >> 13, e2 = gid & 8191, k2 = (2 * e2) & 127;
            float s0 = 0.f, s1 = 0.f;
            for (int c0 = 0; c0 < 64; c0 += 32) {
                unsigned uu[32]; float d0[32], d1[32];
#pragma unroll
                for (int j = 0; j < 32; ++j) { const int unit = bh * 65 + c0 + j; uu[j] = *((const unsigned*)(UT + (size_t)unit * 16384) + e2);
                    const float2 dd = *(const float2*)(DEC + unit * 128 + k2); d0[j] = dd.x; d1[j] = dd.y; }
#pragma unroll
                for (int j = 0; j < 32; ++j) { const int unit = bh * 65 + c0 + j; *((unsigned*)(SP + (size_t)unit * 16384) + e2) = cvtpk(s0, s1);
                    s0 = d0[j] * s0 + bflo(uu[j]); s1 = d1[j] * s1 + bfhi(uu[j]); }
            }
            *((unsigned*)(SP + (size_t)(bh * 65 + 64) * 16384) + e2) = cvtpk(s0, s1);
        }
        }
        {
            const float *w_out = KIN(7), *n2g = KIN(8), *w_gate = KIN(9), *w_up = KIN(10), *w_down = KIN(11);
            bf16_t *Wout_t = W_BF(WS_WOUT), *Wgu_t = W_BF(WS_WGU), *Wdn_t = W_BF(WS_WDN);
            float* scr = (float*)(lds + wave * 16384);
            constexpr int I_OUT = (D / 64) * (D / 32), I_G = (D / 64) * (FF / 32), I_DN = (FF / 64) * (D / 32), NREM = I_OUT + 2 * I_G + I_DN, NIDLE = 3 * 1024;
            const bool idle = bx >= 128; const int idx = (idle ? bx - 128 : bx) * 8 + wave;
            t_run((idle ? 0 : NIDLE) + idx, idle ? NIDLE : NREM, 1024, [&](int it) { int r = it;
                if (r < I_OUT) return TItem{w_out, Wout_t, nullptr, D, D, 0, r}; r -= I_OUT;
                if (r < I_G) return TItem{w_gate, Wgu_t, n2g, D, FF, 1, r}; r -= I_G;
                if (r < I_G) return TItem{w_up, Wgu_t, n2g, D, FF, 2, r}; r -= I_G;
                return TItem{w_down, Wdn_t, nullptr, FF, D, 0, r}; }, scr, lane);
        }
    }
    GSYNC(); PHT1(3); }
    { PHT0(4);
    {
        PH_BEGIN(); const float* hgn = KIN(5); bf16_t *PROJ = W_BF(WS_PROJ), *UT = W_BF(WS_SPREV), *MIX = W_BF(WS_MIX); const float* DB = W_F32(WS_U);
        const bf16_t* KH = *(bf16_t* const __attribute__((address_space(4)))*)(kp + 104); const bf16_t *QT = KH + (size_t)MP * 512, *QB = KH + (size_t)MP * 1024;
        for (int rr = 0; rr < REP_P2C; ++rr) {
            const int bhA = bx >> 6, bhB = 4 + (bx >> 6), cc = (bx & 63) + 1;
            hg_out_stage(bhA, cc, PROJ, UT, lds); hg_out_stage(bhB, cc, PROJ, UT, lds + 69632);
            __syncthreads();
            hg_out_wave(bhA, cc, wave, KH, QT, QB, DB, PROJ, hgn, MIX, lds);
            hg_out_wave(bhB, cc, 7 - wave, KH, QT, QB, DB, PROJ, hgn, MIX, lds + 69632);
            __syncthreads();
        }
    }
    GSYNC(); PHT1(4); }
    { PHT0(5);
    {
        PH_BEGIN(); const float* x = KIN(0); float* out = *(float* const __attribute__((address_space(4)))*)(kp + 104); bf16_t *MIX = W_BF(WS_MIX), *Wout_t = W_BF(WS_WOUT), *H2B = W_BF(WS_LOGF); float* SS2 = W_F32(WS_SMALL + 512 * 1024);
        pg8::Gemm g{MIX, Wout_t, MX, D, D}; pg8::StaticOrder S; S.init(MX, D, G, bx); S.rep = REP_P3;
        pg8::EpiResid E{x, nullptr, H2B, SS2};
        pg8::gemm_phase<pg8::EpiResid, pg8::StaticOrder, false, true>(ldsp, g, S, E);
    }
    GSYNC(); PHT1(5); }
    { PHT0(6);
    {
        PH_BEGIN(); bf16_t *H2B = W_BF(WS_LOGF), *Wgu_t = W_BF(WS_WGU), *HID = W_BF(WS_PROJ); float* SS2 = W_F32(WS_SMALL + 512 * 1024);
        pg8::Gemm g{H2B, Wgu_t, MX, 2 * FF, D}; pg8::StaticOrder S; S.init(MX, 2 * FF, G, bx); S.rep = REP_P4;
        pg8::EpiSwiglu E{HID, SS2};
        pg8::gemm_phase<pg8::EpiSwiglu, pg8::StaticOrder, true, true>(ldsp, g, S, E);
    }
    GSYNC(); PHT1(6); }
    { PHT0(7);
    {
        PH_BEGIN(); const float* fng = KIN(12); float* out = *(float* const __attribute__((address_space(4)))*)(kp + 104); bf16_t *HID = W_BF(WS_PROJ), *Wdn_t = W_BF(WS_WDN); float* SS3 = W_F32(WS_SMALL + 768 * 1024);
        pg8::Gemm g{HID, Wdn_t, MX, D, FF}; pg8::StaticOrder S; S.init(MX, D, G, bx); S.rep = REP_P5;
        pg8::EpiFinal E{W_BF(WS_LOGF), out, SS3, (unsigned*)(ws + 16384), fng};
        pg8::gemm_phase<pg8::EpiFinal, pg8::StaticOrder, false, true>(ldsp, g, S, E);
    }
    PHT1(7); }
}

extern "C" void kernel_launch(void* const* d_in, const int* in_sizes, int n_in, void* d_out, int out_size, void* d_ws, size_t ws_size, hipStream_t stream) {
    static int ready = 0;
    if (!ready) {
        if (n_in != 13 || out_size != MX * D || ws_size < 242 * MiB) { fprintf(stderr, "kernel_launch: unexpected problem shape (n_in %d, out %d, ws %zu)\n", n_in, out_size, ws_size); ready = -1; return; }
        if (hipFuncSetAttribute((const void*)hybrid_fwd, hipFuncAttributeMaxDynamicSharedMemorySize, LDS_BYTES) != hipSuccess) { fprintf(stderr, "kernel_launch: hipFuncSetAttribute failed\n"); ready = -1; return; }
        ready = 1;
    }
    if (ready < 0) return;
    Args a{};
    for (int i = 0; i < 13; ++i) a.in[i] = (const float*)d_in[i];
    a.out = (float*)d_out; a.ws = (unsigned char*)d_ws; a.pad = 0;
    if (hipMemsetAsync(d_ws, 0, 32768, stream) != hipSuccess) { fprintf(stderr, "kernel_launch: memset failed\n"); return; }
    void* args[] = {&a};
    const hipError_t e = hipLaunchCooperativeKernel((const void*)hybrid_fwd, dim3(NWG), dim3(512), args, LDS_BYTES, stream);
    if (e != hipSuccess) fprintf(stderr, "kernel_launch: cooperative launch failed: %s\n", hipGetErrorString(e));
}
```

```cpp
#include <hip/hip_runtime.h>
#include <hip/hip_cooperative_groups.h>
#include <cstdio>
#include <cstdint>
namespace cg = cooperative_groups;
namespace pg8 {
#define PG8_LAS __attribute__((address_space(3)))
typedef unsigned short bf16_t;
typedef short bf16x8 __attribute__((ext_vector_type(8)));
typedef float f32x4 __attribute__((ext_vector_type(4)));
typedef unsigned u32x4 __attribute__((ext_vector_type(4)));
constexpr int BM = 256, BK = 64, HALF = 128, HTB = HALF * BK * 2  , STAGE_BYTES = 8 * HTB, NXCD = 8, WGM = 8;

__host__ __device__ __forceinline__ int lds_byte(int r, int c) { const int st = (r >> 4) * 2 + (c >> 5), rr = r & 15, cc = c & 31, ob = rr * 64 + cc * 2; return st * 1024 + (ob ^ (((ob >> 9) & 1) << 5)); }
__host__ __device__ __forceinline__ void stage_rc(int b, int& R, int& C) { const int st = b / 1024, sb = b % 1024, swz = sb ^ (((sb >> 9) & 1) << 5); R = (st >> 1) * 16 + swz / 64; C = (st & 1) * 32 + (swz % 64) / 2; }
__host__ __device__ __forceinline__ int perm32(int rho) { const int n = rho >> 4, i = rho & 15; return 8 * (i >> 2) + 4 * n + (i & 3); }

struct Unit { int pm, pn; };
struct Gemm { const bf16_t* A; const bf16_t* Bt; int M, N, K; };

struct StaticOrder {
    int nM, nN, nwg, G, c, rep;
    __host__ __device__ void init(int M, int N, int G_, int c_) { nM = M / BM; nN = N / BM; nwg = nM * nN; G = G_; c = c_; rep = 1; }
    __host__ __device__ bool next(int i, Unit& u) const {
        const long L = (long)i * G + c; if (L >= (long)nwg * rep) return false;
        int wgid = (int)(L % nwg); { const int q = nwg / NXCD, r = nwg % NXCD, xcd = wgid % NXCD, off = wgid / NXCD; wgid = (xcd < r ? xcd * (q + 1) : r * (q + 1) + (xcd - r) * q) + off; }
        const int nig = WGM * nN, gid = wgid / nig, fm = gid * WGM, gsz = (nM - fm) < WGM ? (nM - fm) : WGM;
        u.pm = fm + ((wgid % nig) % gsz); u.pn = (wgid % nig) / gsz; return true;
    }
    __device__ __forceinline__ void a_ready(const Unit&) const {}
    __device__ __forceinline__ void done(const Unit&) const {}
};

__device__ __forceinline__ unsigned cvt_pk_bf16(float lo, float hi) { unsigned r; asm volatile("v_cvt_pk_bf16_f32 %0, %1, %2" : "=v"(r) : "v"(lo), "v"(hi)); return r; }
typedef float f32x2 __attribute__((ext_vector_type(2)));
typedef float f32x2_t __attribute__((ext_vector_type(2))); typedef __bf16 bf16x2_t __attribute__((ext_vector_type(2)));
__device__ __forceinline__ unsigned cvtpk(float lo, float hi) { f32x2_t v = {lo, hi}; bf16x2_t b = __builtin_convertvector(v, bf16x2_t); return __builtin_bit_cast(unsigned, b); }
typedef unsigned u32x2 __attribute__((ext_vector_type(2)));

struct EpiProj {
    static constexpr bool PERM = true, AFTER_DRAIN = false;
    bf16_t* proj; float* logf; const float* lbl;
    __device__ __forceinline__ void operator()(const f32x4 (&acc)[2][2][4][2], const Unit& u, int wr, int wc, int fr, int fq) const {
        const int row0 = u.pm * BM + wr * 64 + fr, colt = u.pn * BM, seg = colt >> 9;
        if (seg != 4) {
            const float sc = (seg == 0) ? 0.18033688011112042f : 1.f;
            const int pc = (colt < 2048 ? colt : colt - 512) + wc * 32 + 8 * fq;
#pragma unroll
            for (int ai = 0; ai < 2; ++ai)
#pragma unroll
                for (int m = 0; m < 4; ++m) { bf16_t* rowp = proj + (size_t)(row0 + ai * HALF + m * 16) * 3072 + pc;
#pragma unroll
                    for (int bj = 0; bj < 2; ++bj) { const f32x4 v0 = acc[ai][bj][m][0] * sc, v1 = acc[ai][bj][m][1] * sc;
                        u32x4 w; w.x = cvtpk(v0[0], v0[1]); w.y = cvtpk(v0[2], v0[3]); w.z = cvtpk(v1[0], v1[1]); w.w = cvtpk(v1[2], v1[3]);
                        *(u32x4*)(rowp + bj * HALF) = w; } }
        } else {
            const int c0 = colt - 2048 + wc * 32 + 8 * fq;
            float oml[2][8];
#pragma unroll
            for (int bj = 0; bj < 2; ++bj)
#pragma unroll
                for (int e = 0; e < 8; ++e) { const int c = c0 + bj * HALF + e; oml[bj][e] = 1.0f / (1.0f + __expf(lbl[c] - lbl[512 + c])); }
#pragma unroll
            for (int ai = 0; ai < 2; ++ai)
#pragma unroll
                for (int m = 0; m < 4; ++m) { const int row = row0 + ai * HALF + m * 16; const bool valid = (row % 8320) >= 112; float* rowp = logf + (size_t)row * 512 + c0;
#pragma unroll
                    for (int bj = 0; bj < 2; ++bj)
#pragma unroll
                        for (int n = 0; n < 2; ++n) { f32x4 o;
#pragma unroll
                            for (int e = 0; e < 4; ++e) { const float f = acc[ai][bj][m][n][e]; const float k = oml[bj][4 * n + e] * __builtin_amdgcn_rcpf(1.0f + __expf(f)); o[e] = valid ? __logf(1.0f - k) : 0.f; }
                            *(f32x4*)(rowp + bj * HALF + 4 * n) = o; } }
        }
    }
};

struct EpiResid {
    static constexpr bool PERM = false, AFTER_DRAIN = true;
    const float* base; float* out; bf16_t* outb; float* ss;
    __device__ __forceinline__ void init(f32x4 (&acc)[2][2][4][2], const Unit& u, int wr, int wc, int fr, int fq) const {
        const int col0 = u.pn * BM + wc * 32 + 4 * fq;
#pragma unroll
        for (int ai = 0; ai < 2; ++ai)
#pragma unroll
            for (int m = 0; m < 4; ++m) { const size_t off = (size_t)(u.pm * BM + ai * HALF + wr * 64 + m * 16 + fr) * 1024 + col0;
#pragma unroll
                for (int bj = 0; bj < 2; ++bj)
#pragma unroll
                    for (int n = 0; n < 2; ++n) acc[ai][bj][m][n] = __builtin_nontemporal_load((const f32x4*)(base + off + bj * HALF + n * 16)); }
    }
    __device__ __forceinline__ void fused(f32x4 (&acc)[2][2][4][2], const Unit& u, int wr, int wc, int fr, int fq, PG8_LAS unsigned char* lds, int wid, int lane) const {
        PG8_LAS float* P = (PG8_LAS float*)lds;
        const int col0 = u.pn * BM + wc * 32 + 4 * fq;
#pragma unroll
        for (int ai = 0; ai < 2; ++ai)
#pragma unroll
            for (int m = 0; m < 4; ++m) { const int r = ai * HALF + wr * 64 + m * 16 + fr; const size_t off = (size_t)(u.pm * BM + r) * 1024 + col0; float s = 0.f;
#pragma unroll
                for (int bj = 0; bj < 2; ++bj)
#pragma unroll
                    for (int n = 0; n < 2; ++n) { const f32x4 o = acc[ai][bj][m][n];
                        if (out) *(f32x4*)(out + off + bj * HALF + n * 16) = o;
                        s += (o[0] * o[0] + o[1] * o[1]) + (o[2] * o[2] + o[3] * o[3]);
                        if (outb) { u32x2 w; w.x = cvtpk(o[0], o[1]); w.y = cvtpk(o[2], o[3]); *(u32x2*)(outb + off + bj * HALF + n * 16) = w; } }
                s += __shfl_xor(s, 16); s += __shfl_xor(s, 32);
                if (fq == 0) P[r * 4 + wc] = s; }
        __syncthreads();
        const int tid = wid * 64 + lane;
        if (tid < 256) { const float t = (P[tid * 4 + 0] + P[tid * 4 + 1]) + (P[tid * 4 + 2] + P[tid * 4 + 3]); ss[(size_t)(u.pm * BM + tid) * 4 + u.pn] = t; }
    }
};

struct EpiSwiglu {
    static constexpr bool PERM = true, AFTER_DRAIN = false;
    bf16_t* hid; const float* ss;
    __device__ __forceinline__ void operator()(const f32x4 (&acc)[2][2][4][2], const Unit& u, int wr, int wc, int fr, int fq) const {
        const int row0 = u.pm * BM + wr * 64 + fr, col0 = u.pn * HALF + wc * 32 + 8 * fq;
#pragma unroll
        for (int ai = 0; ai < 2; ++ai)
#pragma unroll
            for (int m = 0; m < 4; ++m) { const int row = row0 + ai * HALF + m * 16; const f32x4 s4 = *(const f32x4*)(ss + (size_t)row * 4);
                const float rstd = __builtin_amdgcn_rsqf(((s4[0] + s4[1]) + (s4[2] + s4[3])) * (1.0f / 1024.0f) + 1e-6f);
                float a[8];
#pragma unroll
                for (int n = 0; n < 2; ++n)
#pragma unroll
                    for (int e = 0; e < 4; ++e) { const float g = acc[ai][0][m][n][e] * rstd, up = acc[ai][1][m][n][e] * rstd; a[4 * n + e] = g * __builtin_amdgcn_rcpf(1.0f + __expf(-g)) * up; }
                u32x4 w; w.x = cvtpk(a[0], a[1]); w.y = cvtpk(a[2], a[3]); w.z = cvtpk(a[4], a[5]); w.w = cvtpk(a[6], a[7]);
                *(u32x4*)(hid + (size_t)row * 2816 + col0) = w; }
    }
};

struct EpiFinal {
    static constexpr bool PERM = false, AFTER_DRAIN = true;
    const bf16_t* base; float* out; float* ss; unsigned* cnt; const float* gf;
    __device__ __forceinline__ void init(f32x4 (&acc)[2][2][4][2], const Unit& u, int wr, int wc, int fr, int fq) const {
        const int col0 = u.pn * BM + wc * 32 + 4 * fq;
#pragma unroll
        for (int ai = 0; ai < 2; ++ai)
#pragma unroll
            for (int m = 0; m < 4; ++m) { const size_t off = (size_t)(u.pm * BM + ai * HALF + wr * 64 + m * 16 + fr) * 1024 + col0;
#pragma unroll
                for (int bj = 0; bj < 2; ++bj)
#pragma unroll
                    for (int n = 0; n < 2; ++n) { const u32x2 bw = __builtin_nontemporal_load((const u32x2*)(base + off + bj * HALF + n * 16));
                        acc[ai][bj][m][n] = (f32x4){__uint_as_float(bw.x << 16), __uint_as_float(bw.x & 0xffff0000u), __uint_as_float(bw.y << 16), __uint_as_float(bw.y & 0xffff0000u)}; } }
    }
    __device__ __forceinline__ void fused(f32x4 (&acc)[2][2][4][2], const Unit& u, int wr, int wc, int fr, int fq, PG8_LAS unsigned char* lds, int wid, int lane) const {
        PG8_LAS float* P = (PG8_LAS float*)lds;
        PG8_LAS float* S = (PG8_LAS float*)(lds + 4096);
        const int col0 = u.pn * BM + wc * 32 + 4 * fq;
#pragma unroll
        for (int ai = 0; ai < 2; ++ai)
#pragma unroll
            for (int m = 0; m < 4; ++m) { const int r = ai * HALF + wr * 64 + m * 16 + fr; float s = 0.f;
#pragma unroll
                for (int bj = 0; bj < 2; ++bj)
#pragma unroll
                    for (int n = 0; n < 2; ++n) { const f32x4 o = acc[ai][bj][m][n]; s += (o[0] * o[0] + o[1] * o[1]) + (o[2] * o[2] + o[3] * o[3]); }
                s += __shfl_xor(s, 16); s += __shfl_xor(s, 32);
                if (fq == 0) P[r * 4 + wc] = s; }
        __syncthreads();
        const int tid = wid * 64 + lane;
        float* slot = ss + (size_t)(u.pm * BM + (tid & 255)) * 4;
        if (tid < 256) { const float t = (P[tid * 4 + 0] + P[tid * 4 + 1]) + (P[tid * 4 + 2] + P[tid * 4 + 3]); __hip_atomic_store(slot + u.pn, t, __ATOMIC_RELAXED, __HIP_MEMORY_SCOPE_AGENT); }
        asm volatile("s_waitcnt vmcnt(0)" ::: "memory");
        unsigned* c = cnt + 64 * u.pm;
        if (lane == 0) __hip_atomic_fetch_add(c, 1u, __ATOMIC_RELAXED, __HIP_MEMORY_SCOPE_AGENT);
        if (wid == 0) {
            unsigned sp = 0;
            while ((unsigned)__builtin_amdgcn_readfirstlane(__hip_atomic_load(c, __ATOMIC_RELAXED, __HIP_MEMORY_SCOPE_AGENT)) < 32u) { __builtin_amdgcn_s_sleep(2); if (++sp > (1u << 22)) break; }
            __builtin_amdgcn_fence(__ATOMIC_ACQUIRE, "agent");
        }
        asm volatile("s_waitcnt vmcnt(0) lgkmcnt(0)" ::: "memory");
        __syncthreads();
        if (tid < 256) { float t4[4];
#pragma unroll
            for (int t = 0; t < 4; ++t) t4[t] = __hip_atomic_load(slot + t, __ATOMIC_RELAXED, __HIP_MEMORY_SCOPE_AGENT);
            S[tid] = 1.0f / sqrtf(((t4[0] + t4[1]) + (t4[2] + t4[3])) * (1.0f / 1024.0f) + 1e-6f); }
        __syncthreads();
#pragma unroll
        for (int ai = 0; ai < 2; ++ai)
#pragma unroll
            for (int m = 0; m < 4; ++m) { const int r = ai * HALF + wr * 64 + m * 16 + fr; const float rs = S[r]; const size_t off = (size_t)(u.pm * BM + r) * 1024 + col0;
#pragma unroll
                for (int bj = 0; bj < 2; ++bj)
#pragma unroll
                    for (int n = 0; n < 2; ++n) { const f32x4 g4 = *(const f32x4*)(gf + col0 + bj * HALF + n * 16); __builtin_nontemporal_store(acc[ai][bj][m][n] * rs * g4, (f32x4*)(out + off + bj * HALF + n * 16)); } }
    }
};
template <class Epi, class Sched, bool ALIGN_EPI = false, bool SP2 = false>
__device__ __forceinline__ void gemm_phase(PG8_LAS unsigned char* lds, const Gemm g, const Sched& S, const Epi& E) {
    int tid_ = threadIdx.x; asm volatile("" : "+v"(tid_));
    const int tid = tid_, wid = __builtin_amdgcn_readfirstlane(tid >> 6), lane = tid & 63, wr = wid >> 2, wc = wid & 3, fr = lane & 15, fq = lane >> 4;
    const int K = g.K, nt = K / BK;
    unsigned voffA[2], voffB[2];
#pragma unroll
    for (int i = 0; i < 2; ++i) { int R, C; stage_rc(tid * 16 + i * 8192, R, C); const int Rb = Epi::PERM ? ((R & ~31) + perm32(R & 31)) : R;
        voffA[i] = (unsigned)(R * K + C) * 2u; voffB[i] = (unsigned)(Rb * K + C) * 2u; }
    const size_t kstep = (size_t)(BK * 2);
    const size_t hstep = (size_t)HALF * K * 2;
    const size_t tstep = 2 * hstep;
    const unsigned ldsw = (unsigned)wid * 1024u;
    const int aoff = lds_byte(wr * 64 + fr, fq * 8), boff = lds_byte(wc * 32 + fr, fq * 8);
#define PG8_SA(b, h) (((b) * 2 + (h)) * HTB)
#define PG8_SB(b, h) ((4 + (b) * 2 + (h)) * HTB)
#define PG8_STAGE(bufoff, gbase, voff) do { _Pragma("unroll") for (int _i = 0; _i < 2; ++_i) \
        __builtin_amdgcn_global_load_lds((const unsigned*)((const char*)(gbase) + (voff)[_i]), (PG8_LAS unsigned*)(lds + (bufoff) + ldsw + _i * 8192), 16, 0, 0); } while (0)
#define PG8_LDA(dst, b, h) do { _Pragma("unroll") for (int m = 0; m < 4; ++m) _Pragma("unroll") for (int k = 0; k < 2; ++k) dst[m][k] = *(const PG8_LAS bf16x8*)(lds + PG8_SA(b, h) + aoff + m * 2048 + k * 1024); } while (0)
#define PG8_LDB(dst, b, h) do { _Pragma("unroll") for (int n = 0; n < 2; ++n) _Pragma("unroll") for (int k = 0; k < 2; ++k) dst[n][k] = *(const PG8_LAS bf16x8*)(lds + PG8_SB(b, h) + boff + n * 2048 + k * 1024); } while (0)
#define PG8_MMA(ai, bj, At, Bt) do { __builtin_amdgcn_s_setprio(1); _Pragma("unroll") for (int m = 0; m < 4; ++m) _Pragma("unroll") for (int n = 0; n < 2; ++n) _Pragma("unroll") for (int k = 0; k < 2; ++k) \
        acc[ai][bj][m][n] = __builtin_amdgcn_mfma_f32_16x16x32_bf16(Bt[n][k], At[m][k], acc[ai][bj][m][n], 0, 0, 0); __builtin_amdgcn_s_setprio(0); } while (0)
#define PG8_WAIT_V(n) asm volatile("s_waitcnt vmcnt(" #n ")" ::: "memory")
#define PG8_WAIT_L(n) asm volatile("s_waitcnt lgkmcnt(" #n ")" ::: "memory")
#define PG8_BAR __builtin_amdgcn_s_barrier()
#define PG8_SCHED __builtin_amdgcn_sched_barrier(0)
    Unit cur, nxt; int ui = 0;
    if (!S.next(0, cur)) return;
    f32x4 acc[2][2][4][2];
    if constexpr (Epi::AFTER_DRAIN) E.init(acc, cur, wr, wc, fr, fq);
    else {
#pragma unroll
    for (int a = 0; a < 2; ++a)
#pragma unroll
        for (int b = 0; b < 2; ++b)
#pragma unroll
            for (int m = 0; m < 4; ++m)
#pragma unroll
                for (int n = 0; n < 2; ++n) acc[a][b][m][n] = (f32x4){0.f, 0.f, 0.f, 0.f};
    }
    bf16x8 At[4][2], B0[2][2], B1[2][2];
    const char* cA = (const char*)g.A + (size_t)cur.pm * tstep; const char* cB = (const char*)g.Bt + (size_t)cur.pn * tstep;
    S.a_ready(cur);
    if constexpr (SP2) {
        PG8_STAGE(PG8_SB(0, 0), cB, voffB); PG8_STAGE(PG8_SB(0, 1), cB + hstep, voffB); PG8_STAGE(PG8_SA(0, 0), cA, voffA); PG8_STAGE(PG8_SA(0, 1), cA + hstep, voffA);
        if (wr == 1) PG8_BAR;
        PG8_WAIT_V(2); PG8_BAR;
        PG8_STAGE(PG8_SB(1, 0), cB + kstep, voffB); PG8_STAGE(PG8_SA(1, 0), cA + kstep, voffA); PG8_STAGE(PG8_SB(1, 1), cB + hstep + kstep, voffB);
        PG8_WAIT_V(6); PG8_BAR;
    } else {
        PG8_STAGE(PG8_SB(0, 0), cB, voffB); PG8_STAGE(PG8_SA(0, 0), cA, voffA); PG8_STAGE(PG8_SB(0, 1), cB + hstep, voffB); PG8_STAGE(PG8_SA(0, 1), cA + hstep, voffA);
        if (wr == 1) PG8_BAR;
        PG8_WAIT_V(4); PG8_BAR;
        PG8_STAGE(PG8_SB(1, 0), cB + kstep, voffB); PG8_STAGE(PG8_SA(1, 0), cA + kstep, voffA); PG8_STAGE(PG8_SB(1, 1), cB + hstep + kstep, voffB);
        PG8_WAIT_V(6); PG8_BAR;
    }
    for (;;) {
        const bool has_next = S.next(ui + 1, nxt);
        const char* nA = has_next ? (const char*)g.A + (size_t)nxt.pm * tstep : cA; const char* nB = has_next ? (const char*)g.Bt + (size_t)nxt.pn * tstep : cB;
        for (int t = 0; t < nt; t += 2) {
            const bool last = (t == nt - 2);
            const char* a1 = cA + (size_t)(t + 1) * kstep;
            const char* a2 = last ? nA : cA + (size_t)(t + 2) * kstep; const char* b2 = last ? nB : cB + (size_t)(t + 2) * kstep;
            const char* a3 = a2 + kstep; const char* b3 = b2 + kstep;
            if (last && has_next) S.a_ready(nxt);
            if constexpr (SP2) {
            PG8_LDB(B0, 0, 0); PG8_LDB(B1, 0, 1); PG8_SCHED; PG8_LDA(At, 0, 0); PG8_STAGE(PG8_SA(1, 1), a1 + hstep, voffA);
            PG8_WAIT_V(8); PG8_WAIT_L(0); PG8_BAR; PG8_MMA(0, 0, At, B0); PG8_MMA(0, 1, At, B1); PG8_BAR; PG8_SCHED;
            PG8_LDA(At, 0, 1); PG8_STAGE(PG8_SB(0, 0), b2, voffB); PG8_STAGE(PG8_SB(0, 1), b2 + hstep, voffB); PG8_STAGE(PG8_SA(0, 0), a2, voffA);
            PG8_WAIT_V(8); PG8_WAIT_L(0); PG8_BAR; PG8_MMA(1, 0, At, B0); PG8_MMA(1, 1, At, B1); PG8_BAR; PG8_SCHED;
            PG8_LDB(B0, 1, 0); PG8_LDB(B1, 1, 1); PG8_SCHED; PG8_LDA(At, 1, 0); PG8_STAGE(PG8_SA(0, 1), a2 + hstep, voffA);
            PG8_WAIT_V(8); PG8_WAIT_L(0); PG8_BAR; PG8_MMA(0, 0, At, B0); PG8_MMA(0, 1, At, B1); PG8_BAR; PG8_SCHED;
            PG8_LDA(At, 1, 1); PG8_STAGE(PG8_SB(1, 0), b3, voffB); PG8_STAGE(PG8_SB(1, 1), b3 + hstep, voffB); PG8_STAGE(PG8_SA(1, 0), a3, voffA);
            PG8_WAIT_V(8); PG8_WAIT_L(0); PG8_BAR; PG8_MMA(1, 0, At, B0); PG8_MMA(1, 1, At, B1); PG8_BAR; PG8_SCHED;
            } else {
            PG8_LDB(B0, 0, 0); PG8_SCHED; PG8_LDA(At, 0, 0); PG8_STAGE(PG8_SA(1, 1), a1 + hstep, voffA);
            PG8_WAIT_L(8); PG8_BAR; PG8_WAIT_L(0); PG8_MMA(0, 0, At, B0); PG8_BAR; PG8_SCHED;
            PG8_LDB(B1, 0, 1); PG8_STAGE(PG8_SB(0, 0), b2, voffB);
            PG8_BAR; PG8_WAIT_L(0); PG8_MMA(0, 1, At, B1); PG8_BAR;
            PG8_LDA(At, 0, 1); PG8_STAGE(PG8_SA(0, 0), a2, voffA);
            PG8_BAR; PG8_WAIT_L(0); PG8_MMA(1, 0, At, B0); PG8_BAR; PG8_SCHED;
            PG8_STAGE(PG8_SB(0, 1), b2 + hstep, voffB);
            PG8_WAIT_V(6); PG8_BAR; PG8_MMA(1, 1, At, B1); PG8_BAR;
            PG8_LDB(B0, 1, 0); PG8_SCHED; PG8_LDA(At, 1, 0); PG8_STAGE(PG8_SA(0, 1), a2 + hstep, voffA);
            PG8_WAIT_L(8); PG8_BAR; PG8_WAIT_L(0); PG8_MMA(0, 0, At, B0); PG8_BAR; PG8_SCHED;
            PG8_LDB(B1, 1, 1); PG8_STAGE(PG8_SB(1, 0), b3, voffB);
            PG8_BAR; PG8_WAIT_L(0); PG8_MMA(0, 1, At, B1); PG8_BAR;
            PG8_LDA(At, 1, 1); PG8_STAGE(PG8_SA(1, 0), a3, voffA);
            PG8_BAR; PG8_WAIT_L(0); PG8_MMA(1, 0, At, B0); PG8_BAR; PG8_SCHED;
            PG8_STAGE(PG8_SB(1, 1), b3 + hstep, voffB);
            PG8_WAIT_V(6); PG8_BAR; PG8_MMA(1, 1, At, B1); PG8_BAR;
            }
        }
        if constexpr (ALIGN_EPI) { if (wr == 0) PG8_BAR; }
        if constexpr (!Epi::AFTER_DRAIN) { E(acc, cur, wr, wc, fr, fq); S.done(cur); }
        if (!has_next) break;
#pragma unroll
        for (int a = 0; a < 2; ++a)
#pragma unroll
            for (int b = 0; b < 2; ++b)
#pragma unroll
                for (int m = 0; m < 4; ++m)
#pragma unroll
                    for (int n = 0; n < 2; ++n) acc[a][b][m][n] = (f32x4){0.f, 0.f, 0.f, 0.f};
        cur = nxt; cA = nA; cB = nB; ++ui;
        if constexpr (ALIGN_EPI) { if (wr == 1) PG8_BAR; }
    }
    PG8_WAIT_V(0);
    if constexpr (!ALIGN_EPI) { if (wr == 0) PG8_BAR; }
    PG8_BAR;
    if constexpr (Epi::AFTER_DRAIN) { E.fused(acc, cur, wr, wc, fr, fq, lds, wid, lane); S.done(cur); }
#undef PG8_SA
#undef PG8_SB
#undef PG8_STAGE
#undef PG8_LDA
#undef PG8_LDB
#undef PG8_MMA
#undef PG8_WAIT_V
#undef PG8_WAIT_L
#undef PG8_BAR
#undef PG8_SCHED
}
}

using pg8::bf16_t; using pg8::bf16x8; using pg8::f32x4; using pg8::u32x4; using pg8::u32x2; using pg8::cvtpk;
typedef float f32x16 __attribute__((ext_vector_type(16)));
constexpr int D = 1024, SEQ = 8192, LP = 8320, NB = 2, MP = NB * LP, MX = NB * SEQ, INW = 3584, PW = 3072, FF = 2816;
constexpr float EPS = 1e-6f;
constexpr size_t MiB = 1u << 20;
constexpr size_t WS_WIN = 1 * MiB, WS_WOUT = 8 * MiB, WS_WGU = 10 * MiB, WS_WDN = 21 * MiB;
constexpr size_t WS_U = 27 * MiB;
constexpr size_t WS_LOGF = 60 * MiB;
constexpr size_t WS_UT = 93 * MiB;
constexpr size_t WS_SPREV = 31 * MiB;
constexpr size_t WS_MIX = 110 * MiB;
constexpr size_t WS_SMALL = 142 * MiB;
constexpr size_t WS_PROJ = 144 * MiB;
constexpr int LDS_BYTES = 147456;
constexpr int NWG = 256;

__device__ __forceinline__ float bflo(unsigned w) { return __uint_as_float(w << 16); }
__device__ __forceinline__ float bfhi(unsigned w) { return __uint_as_float(w & 0xffff0000u); }
__device__ __forceinline__ float wave_sum(float v) {
#pragma unroll
    for (int o = 1; o < 64; o <<= 1) v += __shfl_xor(v, o);
    return v;
}
#define LDS_WAIT() asm volatile("s_waitcnt lgkmcnt(0)" ::: "memory")

struct TItem { const float* W; bf16_t* WT; const float* gk; int K, N, mode, item; };
__device__ __forceinline__ void t_load(const TItem& t, float (&wv)[32], int lane) {
    const int nblk = t.N / 32, kb = t.item / nblk, nb = t.item % nblk, k0 = 64 * kb, n0 = 32 * nb;
#pragma unroll
    for (int i = 0; i < 32; ++i) { const int kk = 2 * i + (lane >> 5); wv[i] = __builtin_nontemporal_load(t.W + (size_t)(k0 + kk) * t.N + n0 + (lane & 31)); }
}
__device__ __forceinline__ void t_finish(const TItem& t, const float (&wv)[32], float* scr, int lane) {
    const int nblk = t.N / 32, kb = t.item / nblk, nb = t.item % nblk, k0 = 64 * kb, n0 = 32 * nb;
#pragma unroll
    for (int i = 0; i < 32; ++i) { const int kk = 2 * i + (lane >> 5); float w = wv[i]; if (t.gk) w *= t.gk[k0 + kk]; scr[kk * 33 + (lane & 31)] = w; }
    LDS_WAIT();
    const int c = lane & 7;
#pragma unroll
    for (int j = 0; j < 4; ++j) { const int n = (lane >> 3) + 8 * j; const float* s = scr + (8 * c) * 33 + n;
        u32x4 o; o.x = cvtpk(s[0 * 33], s[1 * 33]); o.y = cvtpk(s[2 * 33], s[3 * 33]); o.z = cvtpk(s[4 * 33], s[5 * 33]); o.w = cvtpk(s[6 * 33], s[7 * 33]);
        const int nn = n0 + n; const int drow = (t.mode == 0) ? nn : (((nn >> 7) << 8) + (nn & 127) + (t.mode == 2 ? 128 : 0));
        *(u32x4*)(t.WT + (size_t)drow * t.K + k0 + 8 * c) = o; }
    LDS_WAIT();
}
template <class MK> __device__ __forceinline__ void t_run(int first, int end, int step, const MK& mk, float* scr, int lane) {
    if (first >= end) return;
    float wa[32], wb[32]; TItem cur = mk(first); t_load(cur, wa, lane);
    for (int it = first; it < end; it += step) {
        const int nx = it + step; TItem nxt = cur;
        if (nx < end) { nxt = mk(nx); t_load(nxt, wb, lane); }
        t_finish(cur, wa, scr, lane);
        cur = nxt;
#pragma unroll
        for (int i = 0; i < 32; ++i) wa[i] = wb[i];
    }
}
__device__ __forceinline__ void u_load4(int m0, const float* x, const float* meta, f32x4 (&v)[4][4], int lane) {
#pragma unroll
    for (int rr = 0; rr < 4; ++rr) { const int m = m0 + rr, b = m / LP, pos = m % LP;
        const float* src = pos < 112 ? nullptr : (pos < 128 ? meta + (size_t)(pos - 112) * D : x + ((size_t)b * SEQ + pos - 128) * D);
#pragma unroll
        for (int j = 0; j < 4; ++j) v[rr][j] = src ? __builtin_nontemporal_load((const f32x4*)src + lane + 64 * j) : (f32x4){0.f, 0.f, 0.f, 0.f}; }
}
__device__ __forceinline__ void u_finish4(int m0, const f32x4 (&v)[4][4], const float* g, bf16_t* U, int lane) {
    float s[4];
#pragma unroll
    for (int rr = 0; rr < 4; ++rr) { float t = 0.f;
#pragma unroll
        for (int j = 0; j < 4; ++j) t += (v[rr][j][0] * v[rr][j][0] + v[rr][j][1] * v[rr][j][1]) + (v[rr][j][2] * v[rr][j][2] + v[rr][j][3] * v[rr][j][3]);
        s[rr] = t; }
#pragma unroll
    for (int o = 1; o < 64; o <<= 1) {
#pragma unroll
        for (int rr = 0; rr < 4; ++rr) s[rr] += __shfl_xor(s[rr], o); }
#pragma unroll
    for (int rr = 0; rr < 4; ++rr) { const float rstd = __builtin_amdgcn_rsqf(s[rr] * (1.0f / D) + EPS); bf16_t* orow = U + (size_t)(m0 + rr) * D;
#pragma unroll
        for (int j = 0; j < 4; ++j) { const f32x4 g4 = ((const f32x4*)g)[lane + 64 * j]; const f32x4 o = v[rr][j] * rstd * g4;
            u32x2 w; w.x = cvtpk(o[0], o[1]); w.y = cvtpk(o[2], o[3]); ((u32x2*)orow)[lane + 64 * j] = w; } }
}

__device__ __forceinline__ void stage_vT(const bf16_t* PROJ, size_t m0, int h, bf16_t* vT) {
    const int tid = threadIdx.x;
#pragma unroll
    for (int ii = 0; ii < 2; ++ii) { const int it = tid + 512 * ii, sp = it & 63, vc = it >> 6;
        const bf16_t* src = PROJ + (m0 + 2 * sp) * PW + 2048 + h * 128 + vc * 8;
        const u32x4 d0 = *(const u32x4*)src, d1 = *(const u32x4*)(src + PW);
#pragma unroll
        for (int j = 0; j < 4; ++j) { *(unsigned*)(vT + (vc * 8 + 2 * j) * 136 + 2 * sp) = (d0[j] & 0xffffu) | (d1[j] << 16);
            *(unsigned*)(vT + (vc * 8 + 2 * j + 1) * 136 + 2 * sp) = (d0[j] >> 16) | (d1[j] & 0xffff0000u); } }
}
__device__ __forceinline__ f32x4 exp4(f32x4 v) { return (f32x4){__expf(v[0]), __expf(v[1]), __expf(v[2]), __expf(v[3])}; }
__device__ __forceinline__ void hg_local_unit(int unit, bool light, const float* LOGF, const bf16_t* PROJ, bf16_t* KH, bf16_t* QT, bf16_t* QB, float* DB, bf16_t* UT, float* DEC, unsigned* done_cnt, unsigned char* lds) {
    const int tid = threadIdx.x, lane = tid & 63, w = __builtin_amdgcn_readfirstlane(tid >> 6);
    const int bh = unit / 65, c = unit % 65, b = bh >> 2, h = bh & 3;
    const size_t m0 = (size_t)b * LP + (size_t)c * 128;
    bf16_t* kT = (bf16_t*)lds;
    bf16_t* vT = (bf16_t*)(lds + 34816);
    float* tot = (float*)(lds + 69632);
    const int kq = tid & 31, rg = tid >> 5;
    if (!light) stage_vT(PROJ, m0, h, vT);
    const size_t rbase = (m0 + rg * 8) * 512 + h * 128 + 4 * kq;
    f32x4 pre[8], kk[8]; u32x2 qw[8]; f32x4 run = (f32x4){0.f, 0.f, 0.f, 0.f};
#pragma unroll
    for (int i = 0; i < 8; ++i) pre[i] = __builtin_nontemporal_load((const f32x4*)(LOGF + rbase + (size_t)i * 512));
#pragma unroll
    for (int i = 0; i < 8; ++i) qw[i] = *(const u32x2*)(PROJ + (m0 + rg * 8 + i) * PW + 1536 + h * 128 + 4 * kq);
#pragma unroll
    for (int i = 0; i < 8; ++i) { const f32x4 lf = pre[i]; run += lf; pre[i] = run; kk[i] = 1.0f - exp4(lf); }
    *(f32x4*)(tot + rg * 128 + 4 * kq) = run;
    __syncthreads();
    f32x4 off = (f32x4){0.f, 0.f, 0.f, 0.f}, Bj = off, blast = off; const int g0 = rg & ~1;
#pragma unroll
    for (int g = 0; g < 16; ++g) { const f32x4 t = *(const f32x4*)(tot + g * 128 + 4 * kq); if (g < rg) off += t; if (g < g0) Bj += t; blast += t; }
    const f32x4 Ej = Bj + *(const f32x4*)(tot + g0 * 128 + 4 * kq) + *(const f32x4*)(tot + (g0 + 1) * 128 + 4 * kq);
    const f32x4 cE = exp4(blast - Ej);
    u32x4 ktw[4];
#pragma unroll
    for (int i = 0; i < 8; i += 2) {
        const f32x4 b0 = off + pre[i], b1 = off + pre[i + 1];
        const f32x4 kh0 = kk[i] * exp4(Ej - b0), kh1 = kk[i + 1] * exp4(Ej - b1);
        const f32x4 q0 = (f32x4){bflo(qw[i].x), bfhi(qw[i].x), bflo(qw[i].y), bfhi(qw[i].y)}, q1 = (f32x4){bflo(qw[i + 1].x), bfhi(qw[i + 1].x), bflo(qw[i + 1].y), bfhi(qw[i + 1].y)};
        const f32x4 qt0 = q0 * exp4(b0 - Bj), qt1 = q1 * exp4(b1 - Bj), qb0 = q0 * exp4(b0), qb1 = q1 * exp4(b1);
        u32x2 s;
        s.x = cvtpk(kh0[0], kh0[1]); s.y = cvtpk(kh0[2], kh0[3]); *(u32x2*)(KH + rbase + (size_t)i * 512) = s;
        s.x = cvtpk(kh1[0], kh1[1]); s.y = cvtpk(kh1[2], kh1[3]); *(u32x2*)(KH + rbase + (size_t)(i + 1) * 512) = s;
        s.x = cvtpk(qt0[0], qt0[1]); s.y = cvtpk(qt0[2], qt0[3]); *(u32x2*)(QT + rbase + (size_t)i * 512) = s;
        s.x = cvtpk(qt1[0], qt1[1]); s.y = cvtpk(qt1[2], qt1[3]); *(u32x2*)(QT + rbase + (size_t)(i + 1) * 512) = s;
        s.x = cvtpk(qb0[0], qb0[1]); s.y = cvtpk(qb0[2], qb0[3]); *(u32x2*)(QB + rbase + (size_t)i * 512) = s;
        s.x = cvtpk(qb1[0], qb1[1]); s.y = cvtpk(qb1[2], qb1[3]); *(u32x2*)(QB + rbase + (size_t)(i + 1) * 512) = s;
        const f32x4 u0 = kh0 * cE, u1 = kh1 * cE;
#pragma unroll
        for (int cc = 0; cc < 4; ++cc) ktw[cc][i >> 1] = cvtpk(u0[cc], u1[cc]);
    }
#pragma unroll
    for (int cc = 0; cc < 4; ++cc) *(u32x4*)(kT + (4 * kq + cc) * 136 + rg * 8) = ktw[cc];
    if ((rg & 1) == 0) *(f32x4*)(DB + (size_t)unit * 1024 + (rg >> 1) * 128 + 4 * kq) = exp4(Ej - Bj);
    if (rg == 0) { const f32x4 dv = exp4(blast); unsigned long long* dp = (unsigned long long*)(DEC + unit * 128 + 4 * kq);
        __hip_atomic_store(dp, (unsigned long long)__float_as_uint(dv[0]) | ((unsigned long long)__float_as_uint(dv[1]) << 32), __ATOMIC_RELAXED, __HIP_MEMORY_SCOPE_AGENT);
        __hip_atomic_store(dp + 1, (unsigned long long)__float_as_uint(dv[2]) | ((unsigned long long)__float_as_uint(dv[3]) << 32), __ATOMIC_RELAXED, __HIP_MEMORY_SCOPE_AGENT); }
    __syncthreads();
    if (light) return;
    const int r = lane & 15, quad = lane >> 4;
    f32x4 acc[8];
#pragma unroll
    for (int vt = 0; vt < 8; ++vt) acc[vt] = (f32x4){0.f, 0.f, 0.f, 0.f};
#pragma unroll
    for (int ss = 0; ss < 4; ++ss) { const bf16x8 a = *(const bf16x8*)(kT + (16 * w + r) * 136 + 32 * ss + quad * 8);
#pragma unroll
        for (int vt = 0; vt < 8; ++vt) { const bf16x8 bb = *(const bf16x8*)(vT + (16 * vt + r) * 136 + 32 * ss + quad * 8); acc[vt] = __builtin_amdgcn_mfma_f32_16x16x32_bf16(a, bb, acc[vt], 0, 0, 0); } }
#pragma unroll
    for (int vt = 0; vt < 8; ++vt) { u32x2 o; o.x = cvtpk(acc[vt][0], acc[vt][1]); o.y = cvtpk(acc[vt][2], acc[vt][3]);
        __hip_atomic_store((unsigned long long*)(UT + (size_t)unit * 16384 + (16 * vt + r) * 128 + 16 * w + quad * 4), (unsigned long long)o.x | ((unsigned long long)o.y << 32), __ATOMIC_RELAXED, __HIP_MEMORY_SCOPE_AGENT); }
    asm volatile("s_waitcnt vmcnt(0)" ::: "memory");
    __syncthreads();
    if (tid == 0) __hip_atomic_fetch_add(done_cnt + 64 * bh, 1u, __ATOMIC_RELAXED, __HIP_MEMORY_SCOPE_AGENT);
}

__device__ __forceinline__ void attn_unit(int au, const bf16_t* PROJ, const float* sbn, bf16_t* MIX, bf16_t* vl) {
    const int lane = threadIdx.x & 63, r32 = lane & 31, hh = lane >> 5;
    const int qt = au & 255, head = (au >> 8) & 7, b = au >> 11;
    const int q0 = 128 + 32 * qt; const size_t mb = (size_t)b * LP;
    const bf16_t* Qp = PROJ + (mb + q0 + r32) * PW + head * 64 + 8 * hh;
    bf16x8 qf[4];
#pragma unroll
    for (int ds = 0; ds < 4; ++ds) qf[ds] = *(const bf16x8*)(Qp + 16 * ds);
    f32x16 o0, o1;
#pragma unroll
    for (int i = 0; i < 16; ++i) { o0[i] = 0.f; o1[i] = 0.f; }
    float carry = 0.f; const int qpos = q0 + r32;
    const int prow = lane >> 3, pcol = (lane & 7) * 8;
    const bf16_t* Kbase = PROJ + (mb + r32) * PW + 512 + head * 64 + 8 * hh;
    const bf16_t* Vbase = PROJ + (mb + prow) * PW + 1024 + head * 64 + pcol;
    int kt = q0 >> 5;
    bf16x8 kn[4]; u32x4 vn[4];
#pragma unroll
    for (int ds = 0; ds < 4; ++ds) kn[ds] = *(const bf16x8*)(Kbase + (size_t)(32 * kt) * PW + 16 * ds);
#pragma unroll
    for (int i = 0; i < 4; ++i) vn[i] = *(const u32x4*)(Vbase + (size_t)(32 * kt + 8 * i) * PW);
    for (;;) {
        const int kv0 = 32 * kt; const bool more = kt > 3;
        bf16x8 kf[4];
#pragma unroll
        for (int ds = 0; ds < 4; ++ds) kf[ds] = kn[ds];
#pragma unroll
        for (int i = 0; i < 4; ++i) *(u32x4*)(vl + (prow + 8 * i) * 72 + pcol) = vn[i];
        asm volatile("" ::: "memory");
        if (more) {
#pragma unroll
            for (int ds = 0; ds < 4; ++ds) kn[ds] = *(const bf16x8*)(Kbase + (size_t)(kv0 - 32) * PW + 16 * ds);
#pragma unroll
            for (int i = 0; i < 4; ++i) vn[i] = *(const u32x4*)(Vbase + (size_t)(kv0 - 32 + 8 * i) * PW);
        }
        f32x16 x;
#pragma unroll
        for (int i = 0; i < 16; ++i) x[i] = 0.f;
#pragma unroll
        for (int ds = 0; ds < 4; ++ds) x = __builtin_amdgcn_mfma_f32_32x32x16_bf16(kf[ds], qf[ds], x, 0, 0, 0);
        float be[16], om[16];
        const bool edge = (kt == (q0 >> 5)) || (kt == 3);
#pragma unroll
        for (int i = 0; i < 16; ++i) { const float zp = x[i]; const float u = __builtin_amdgcn_exp2f(-fabsf(zp)); const float s = __builtin_amdgcn_rcpf(1.0f + u), us = u * s;
            be[i] = zp > 0.f ? s : us; om[i] = zp > 0.f ? us : s; }
        if (edge) {
#pragma unroll
            for (int i = 0; i < 16; ++i) { const int kv = kv0 + (i & 3) + 8 * (i >> 2) + 4 * hh; const bool vis = (kv < qpos) && (kv >= 112); be[i] = vis ? be[i] : 0.f; om[i] = vis ? om[i] : 1.0f; } }
        float gp[4], pp[4], T[4]; float run = 1.0f;
#pragma unroll
        for (int g = 0; g < 4; ++g) gp[g] = (om[4 * g] * om[4 * g + 1]) * (om[4 * g + 2] * om[4 * g + 3]);
#pragma unroll
        for (int g = 0; g < 4; ++g) pp[g] = __shfl_xor(gp[g], 32);
#pragma unroll
        for (int g = 3; g >= 0; --g) { T[g] = hh == 0 ? run * pp[g] : run; run *= gp[g] * pp[g]; }
        const float C = __builtin_amdgcn_exp2f(carry);
        float wv[16];
#pragma unroll
        for (int g = 0; g < 4; ++g) { float a = C * T[g];
#pragma unroll
            for (int e = 3; e >= 0; --e) { const int i = 4 * g + e; wv[i] = be[i] * a; a *= om[i]; } }
        carry += __builtin_amdgcn_logf(run);
        bf16x8 xs[2];
#pragma unroll
        for (int s = 0; s < 2; ++s) { u32x4 pw; pw.x = cvtpk(wv[8 * s], wv[8 * s + 1]); pw.y = cvtpk(wv[8 * s + 2], wv[8 * s + 3]); pw.z = cvtpk(wv[8 * s + 4], wv[8 * s + 5]); pw.w = cvtpk(wv[8 * s + 6], wv[8 * s + 7]);
            xs[s] = __builtin_bit_cast(bf16x8, pw); }
        const bf16_t* vp = vl + (4 * hh) * 72 + r32;
#pragma unroll
        for (int s = 0; s < 2; ++s) {
            bf16x8 va, vb;
#pragma unroll
            for (int j = 0; j < 8; ++j) { const bf16_t* p = vp + (16 * s + 8 * (j >> 2) + (j & 3)) * 72; va[j] = (short)p[0]; vb[j] = (short)p[32]; }
            o0 = __builtin_amdgcn_mfma_f32_32x32x16_bf16(va, xs[s], o0, 0, 0, 0);
            o1 = __builtin_amdgcn_mfma_f32_32x32x16_bf16(vb, xs[s], o1, 0, 0, 0);
        }
        asm volatile("" ::: "memory");
        if (!more || __all(carry < -152.0f)) break;
        --kt;
    }
    float ss = 0.f;
#pragma unroll
    for (int i = 0; i < 16; ++i) ss += o0[i] * o0[i] + o1[i] * o1[i];
    ss += __shfl_xor(ss, 32);
    const float rstd = 1.0f / sqrtf(ss * (1.0f / 64.0f) + EPS);
    bf16_t* orow = MIX + ((size_t)b * SEQ + q0 - 128 + r32) * D + head * 64;
#pragma unroll
    for (int g = 0; g < 4; ++g) { const int d0 = 8 * g + 4 * hh;
        const f32x4 g0 = *(const f32x4*)(sbn + head * 64 + d0), g1 = *(const f32x4*)(sbn + head * 64 + 32 + d0);
        u32x2 w0, w1;
        w0.x = cvtpk(o0[4 * g] * rstd * g0[0], o0[4 * g + 1] * rstd * g0[1]); w0.y = cvtpk(o0[4 * g + 2] * rstd * g0[2], o0[4 * g + 3] * rstd * g0[3]);
        w1.x = cvtpk(o1[4 * g] * rstd * g1[0], o1[4 * g + 1] * rstd * g1[1]); w1.y = cvtpk(o1[4 * g + 2] * rstd * g1[2], o1[4 * g + 3] * rstd * g1[3]);
        *(u32x2*)(orow + d0) = w0; *(u32x2*)(orow + 32 + d0) = w1; }
}

__device__ __forceinline__ void hg_out_stage(int bh, int c, const bf16_t* PROJ, const bf16_t* UT, unsigned char* lds) {
    const int tid = threadIdx.x; const int b = bh >> 2, h = bh & 3, unit = bh * 65 + c;
    const size_t m0 = (size_t)b * LP + (size_t)c * 128;
    stage_vT(PROJ, m0, h, (bf16_t*)lds);
    bf16_t* sT = (bf16_t*)(lds + 34816);
#pragma unroll
    for (int ii = 0; ii < 4; ++ii) { const int p = tid + 512 * ii, s = p >> 4, vc = p & 15;
        const u32x4 e = *(const u32x4*)(UT + (size_t)unit * 16384 + s * 128 + vc * 8); *(u32x4*)(sT + s * 136 + vc * 8) = e; }
}
__device__ __forceinline__ void hg_out_wave(int bh, int c, int i, const bf16_t* KH, const bf16_t* QT, const bf16_t* QB, const float* DB, const bf16_t* PROJ, const float* hgn, bf16_t* MIX, const unsigned char* lds) {
    const int lane = threadIdx.x & 63, r = lane & 15, quad = lane >> 4;
    const int b = bh >> 2, h = bh & 3, unit = bh * 65 + c;
    const size_t m0 = (size_t)b * LP + (size_t)c * 128;
    const bf16_t* vT = (const bf16_t*)lds; const bf16_t* sT = (const bf16_t*)(lds + 34816);
    const size_t mt = m0 + 16 * i + r; const int kc = h * 128 + quad * 8;
    const bf16_t* KHl = KH + (m0 + r) * 512 + kc;
    const float* DBl = DB + (size_t)unit * 1024 + quad * 8;
    bf16x8 qtl[4], qbr[4]; float g[4][8]; u32x4 khn[4]; f32x4 dn[4][2];
#pragma unroll
    for (int ks = 0; ks < 4; ++ks) { qtl[ks] = *(const bf16x8*)(QT + mt * 512 + kc + 32 * ks); qbr[ks] = *(const bf16x8*)(QB + mt * 512 + kc + 32 * ks);
        khn[ks] = *(const u32x4*)(KHl + (size_t)(16 * i) * 512 + 32 * ks);
        const float* dp = DBl + i * 128 + 32 * ks; dn[ks][0] = *(const f32x4*)dp; dn[ks][1] = *(const f32x4*)(dp + 4); }
    f32x4 o[8];
#pragma unroll
    for (int vt = 0; vt < 8; ++vt) o[vt] = (f32x4){0.f, 0.f, 0.f, 0.f};
    f32x4 scA = (f32x4){0.f, 0.f, 0.f, 0.f}, scB = scA; int jA = i;
    for (int jb = i; jb >= 0; --jb) {
        const int mode = (jb == i) ? 0 : ((jb == i - 1) ? 1 : 2);
        u32x4 kh[4];
#pragma unroll
        for (int ks = 0; ks < 4; ++ks) { kh[ks] = khn[ks];
            if (mode == 0) {
#pragma unroll
                for (int j = 0; j < 4; ++j) { g[ks][j] = __builtin_amdgcn_rcpf(fmaxf(dn[ks][0][j], 1e-30f)); g[ks][4 + j] = __builtin_amdgcn_rcpf(fmaxf(dn[ks][1][j], 1e-30f)); } }
            else if (mode == 2) {
#pragma unroll
                for (int j = 0; j < 4; ++j) { g[ks][j] *= dn[ks][0][j]; g[ks][4 + j] *= dn[ks][1][j]; } } }
        if (jb > 0) {
#pragma unroll
            for (int ks = 0; ks < 4; ++ks) { khn[ks] = *(const u32x4*)(KHl + (size_t)(16 * (jb - 1)) * 512 + 32 * ks);
                const float* dp = DBl + jb * 128 + 32 * ks; dn[ks][0] = *(const f32x4*)dp; dn[ks][1] = *(const f32x4*)(dp + 4); } }
        f32x4 sc = (f32x4){0.f, 0.f, 0.f, 0.f};
#pragma unroll
        for (int ks = 0; ks < 4; ++ks) { u32x4 t = kh[ks];
            if (mode != 1) {
#pragma unroll
                for (int j = 0; j < 4; ++j) t[j] = cvtpk(bflo(kh[ks][j]) * g[ks][2 * j], bfhi(kh[ks][j]) * g[ks][2 * j + 1]); }
            sc = __builtin_amdgcn_mfma_f32_16x16x32_bf16(__builtin_bit_cast(bf16x8, t), qtl[ks], sc, 0, 0, 0); }
        if (mode == 0) {
#pragma unroll
            for (int jj = 0; jj < 4; ++jj) if (quad * 4 + jj > r) sc[jj] = 0.f;
#pragma unroll
            for (int ks = 0; ks < 4; ++ks)
#pragma unroll
                for (int j = 0; j < 8; ++j) g[ks][j] = 1.0f; }
        const bool second = ((i - jb) & 1) != 0;
        if (!second) { scA = sc; jA = jb; scB = (f32x4){0.f, 0.f, 0.f, 0.f}; } else scB = sc;
        if (second || jb == 0) {
            u32x4 pp; pp.x = cvtpk(scA[0], scA[1]); pp.y = cvtpk(scA[2], scA[3]); pp.z = cvtpk(scB[0], scB[1]); pp.w = cvtpk(scB[2], scB[3]);
            const bf16x8 pf = __builtin_bit_cast(bf16x8, pp);
            const int cA = 16 * jA + quad * 4, cB = 16 * jb + quad * 4;
#pragma unroll
            for (int vt = 0; vt < 8; ++vt) { const bf16_t* vp = vT + (16 * vt + r) * 136;
                const u32x2 a0 = *(const u32x2*)(vp + cA), a1 = *(const u32x2*)(vp + cB); u32x4 av; av.x = a0.x; av.y = a0.y; av.z = a1.x; av.w = a1.y;
                o[vt] = __builtin_amdgcn_mfma_f32_16x16x32_bf16(__builtin_bit_cast(bf16x8, av), pf, o[vt], 0, 0, 0); }
        }
    }
#pragma unroll
    for (int ks = 0; ks < 4; ++ks)
#pragma unroll
        for (int vt = 0; vt < 8; ++vt) { const bf16x8 sf = *(const bf16x8*)(sT + (16 * vt + r) * 136 + 32 * ks + quad * 8); o[vt] = __builtin_amdgcn_mfma_f32_16x16x32_bf16(sf, qbr[ks], o[vt], 0, 0, 0); }
    float ss = 0.f;
#pragma unroll
    for (int vt = 0; vt < 8; ++vt) ss += (o[vt][0] * o[vt][0] + o[vt][1] * o[vt][1]) + (o[vt][2] * o[vt][2] + o[vt][3] * o[vt][3]);
    ss += __shfl_xor(ss, 16); ss += __shfl_xor(ss, 32);
    const float rstd = __builtin_amdgcn_rsqf(ss * (1.0f / 128.0f) + EPS);
    const bf16_t* gp = PROJ + mt * PW + 2560 + h * 128 + quad * 4;
    bf16_t* op = MIX + ((size_t)b * SEQ + (size_t)c * 128 - 128 + 16 * i + r) * D + 512 + h * 128 + quad * 4;
#pragma unroll
    for (int vt = 0; vt < 8; ++vt) { const u32x2 gw = *(const u32x2*)(gp + 16 * vt); const f32x4 gn = *(const f32x4*)(hgn + h * 128 + 16 * vt + quad * 4);
        const float g0 = bflo(gw.x), g1 = bfhi(gw.x), g2 = bflo(gw.y), g3 = bfhi(gw.y);
        u32x2 ow; ow.x = cvtpk(o[vt][0] * rstd * gn[0] * (g0 * __builtin_amdgcn_rcpf(1.0f + __expf(-g0))), o[vt][1] * rstd * gn[1] * (g1 * __builtin_amdgcn_rcpf(1.0f + __expf(-g1))));
        ow.y = cvtpk(o[vt][2] * rstd * gn[2] * (g2 * __builtin_amdgcn_rcpf(1.0f + __expf(-g2))), o[vt][3] * rstd * gn[3] * (g3 * __builtin_amdgcn_rcpf(1.0f + __expf(-g3))));
        *(u32x2*)(op + 16 * vt) = ow; }
}

#define LAS __attribute__((address_space(3)))
#define XB_TMO      128
#define XB_XCNT(j)  (256  + 64 * (j))
#define XB_XSUB(j)  (1280 + 64 * (j))
#define XB_XGEN(j)  (2304 + 64 * (j))
#define XB_TOP      3328
#define XB_TOPGEN   3392
#define XCD_BAR_WORDS 3456
#define XB_SPIN_CAP (1u << 18)

__device__ __forceinline__ unsigned xb_ld(unsigned* p)              { return __hip_atomic_load(p, __ATOMIC_RELAXED, __HIP_MEMORY_SCOPE_AGENT); }
__device__ __forceinline__ unsigned xb_add(unsigned* p, unsigned v) { return __hip_atomic_fetch_add(p, v, __ATOMIC_RELAXED, __HIP_MEMORY_SCOPE_AGENT); }
__device__ __forceinline__ unsigned xb_xcc_id() { return (unsigned)__builtin_amdgcn_s_getreg((3 << 11) | 20) & 0xFu; }
#define XB_SPIN(cond, bar) do { unsigned _sp = 0; while (cond) { __builtin_amdgcn_s_sleep(1); \
    if ((++_sp & 255u) == 0u) { if (xb_ld(&(bar)[XB_TMO])) break; if (_sp > XB_SPIN_CAP) { atomicAdd(&(bar)[XB_TMO], 1u); break; } } } } while (0)

struct XcdBarrier {
    unsigned* bar; unsigned x;
    volatile LAS unsigned* st;
};

__device__ __forceinline__ XcdBarrier xcd_barrier_post(unsigned* bar, volatile LAS unsigned* st) {
    XcdBarrier b; b.bar = bar; b.x = xb_xcc_id(); b.st = st;
    if (threadIdx.x == 0) (void)xb_add(&bar[XB_XCNT(b.x)], 1u);
    return b;
}
__device__ __forceinline__ void xcd_barrier_complete(unsigned* bar, unsigned x, unsigned& nloc, unsigned& nx) {
    const unsigned G = gridDim.x * gridDim.y * gridDim.z;
    unsigned sum, cnt, mine, sp = 0u;
    for (;;) {
        sum = 0u; cnt = 0u; mine = 0u;
#pragma unroll
        for (unsigned j = 0; j < 16; ++j) { const unsigned c = xb_ld(&bar[XB_XCNT(j)]); sum += c; cnt += (c > 0u) ? 1u : 0u; mine = (j == x) ? c : mine; }
        if (sum == G) break;
        __builtin_amdgcn_s_sleep(1);
        if ((++sp & 255u) == 0u) { if (xb_ld(&bar[XB_TMO])) break; if (sp > XB_SPIN_CAP) { atomicAdd(&bar[XB_TMO], 1u); break; } }
    }
    nloc = mine > 0u ? mine : 1u; nx = cnt > 0u ? cnt : 1u;
}

__device__ __forceinline__ void xcd_barrier(const XcdBarrier& b) {
    asm volatile("s_waitcnt vmcnt(0)" ::: "memory");
    __syncthreads();
    if (threadIdx.x == 0) {
        unsigned* bar = b.bar;
        __builtin_amdgcn_s_waitcnt(0);
        unsigned nloc = b.st[0], nx = b.st[1];
        if (nloc == 0u) { xcd_barrier_complete(bar, b.x, nloc, nx); b.st[0] = nloc; b.st[1] = nx; }
        const unsigned old = xb_add(&bar[XB_XSUB(b.x)], 1u);
        const unsigned gen = old / nloc;
        if (old + 1u == (gen + 1u) * nloc) {
            __builtin_amdgcn_fence(__ATOMIC_RELEASE, "agent");
            asm volatile("s_waitcnt vmcnt(0)" ::: "memory");
            const unsigned og = xb_add(&bar[XB_TOP], 1u);
            const unsigned tg = og / nx;
            if (og + 1u == (tg + 1u) * nx) xb_add(&bar[XB_TOPGEN], 1u);
            else XB_SPIN(xb_ld(&bar[XB_TOPGEN]) == tg, bar);
            __builtin_amdgcn_fence(__ATOMIC_ACQUIRE, "agent");
            xb_add(&bar[XB_XGEN(b.x)], 1u);
            asm volatile("s_waitcnt vmcnt(0)" ::: "memory");
        } else {
            XB_SPIN(xb_ld(&bar[XB_XGEN(b.x)]) == gen, bar);
            __builtin_amdgcn_fence(__ATOMIC_ACQUIRE, "agent");
            asm volatile("s_waitcnt vmcnt(0)" ::: "memory");
        }
    }
    __syncthreads();
}

#ifndef PROBE_PHASE
#define PROBE_PHASE -1
#endif
#define PHT0(k) unsigned long long pt0_ = 0; if (PROBE_PHASE == (k)) pt0_ = __builtin_amdgcn_s_memrealtime()
#define PHT1(k) do { if (PROBE_PHASE == (k)) { const unsigned long long pt1_ = __builtin_amdgcn_s_memrealtime(), pd_ = pt1_ - pt0_; while (__builtin_amdgcn_s_memrealtime() - pt1_ < pd_) __builtin_amdgcn_s_sleep(8); } } while (0)
#ifndef REP_HL
#define REP_HL 1
#endif
#ifndef REP_AT
#define REP_AT 1
#endif
#ifndef REP_P2C
#define REP_P2C 1
#endif
#ifndef REP_SYNC
#define REP_SYNC 1
#endif
#ifndef REP_P0
#define REP_P0 1
#endif
#ifndef REP_P3
#define REP_P3 1
#endif
#ifndef REP_P5
#define REP_P5 1
#endif
#ifndef REP_P2B
#define REP_P2B 1
#endif
#ifndef REP_P1
#define REP_P1 1
#endif
#ifndef REP_P4
#define REP_P4 1
#endif
#define GSYNC() do { for (int rs_ = 0; rs_ < REP_SYNC; ++rs_) xcd_barrier(xbar); } while (0)
struct Args { const float* in[13]; float* out; unsigned char* ws; long long pad; };
__global__ void __launch_bounds__(512, 2) hybrid_fwd(Args a) {
    extern __shared__ __attribute__((aligned(16))) unsigned char lds[];
    cg::grid_group grid = cg::this_grid();
    const int tid = threadIdx.x, lane = tid & 63, wave = __builtin_amdgcn_readfirstlane(tid >> 6);
    const int G = gridDim.x, bx = blockIdx.x;
    typedef const __attribute__((address_space(4))) unsigned char* kptr_t;
    kptr_t kp = (kptr_t)__builtin_amdgcn_kernarg_segment_ptr();
#define KIN(i) (*(const float* const __attribute__((address_space(4)))*)(kp + 8 * (i)))
#define PH_BEGIN() asm volatile("" : "+s"(kp)); unsigned char* const ws = *(unsigned char* const __attribute__((address_space(4)))*)(kp + 112)
#define W_BF(off) ((bf16_t*)(ws + (off)))
#define W_F32(off) ((float*)(ws + (off)))
    volatile LAS unsigned* bst = (volatile LAS unsigned*)((LAS unsigned char*)lds + LDS_BYTES - 64);
    if (tid == 0) { bst[0] = 0u; bst[1] = 0u; }
    __syncthreads();
    const XcdBarrier xbar = xcd_barrier_post((unsigned*)a.ws, bst);
    PG8_LAS unsigned char* ldsp = (PG8_LAS unsigned char*)lds;

    { PHT0(0);
    {
        PH_BEGIN(); const float *x = KIN(0), *meta = KIN(1), *n1g = KIN(2), *w_in = KIN(3);
        bf16_t *Win_t = W_BF(WS_WIN), *U = W_BF(WS_U);
        float* scr = (float*)(lds + wave * 16384);
        const int gw = bx * 8 + wave, NGW = G * 8;
        constexpr int I_IN = (D / 64) * (INW / 32);
        constexpr int NGRP = MP / 4;
        f32x4 va[4][4], vb[4][4]; const int g0 = gw, g1 = gw + NGW, g2 = gw + 2 * NGW;
        if (g0 < NGRP) u_load4(4 * g0, x, meta, va, lane);
        if (g1 < NGRP) u_load4(4 * g1, x, meta, vb, lane);
        if (g0 < NGRP) u_finish4(4 * g0, va, n1g, U, lane);
        if (g1 < NGRP) u_finish4(4 * g1, vb, n1g, U, lane);
        for (int g = g2; g < NGRP; g += NGW) { u_load4(4 * g, x, meta, va, lane); u_finish4(4 * g, va, n1g, U, lane); }
        t_run(gw, I_IN, NGW, [&](int it) { return TItem{w_in, Win_t, nullptr, D, INW, 0, it}; }, scr, lane);
    }
    if (a.pad != 0) grid.sync();
    GSYNC(); PHT1(0); }
    { PHT0(1);
    {
        PH_BEGIN(); const float* lbl = KIN(6); bf16_t *U = W_BF(WS_U), *Win_t = W_BF(WS_WIN), *PROJ = W_BF(WS_PROJ); float* LOGF = W_F32(WS_LOGF);
        pg8::Gemm g{U, Win_t, MP, INW, D}; pg8::StaticOrder S; S.init(MP, INW, G, bx); S.rep = REP_P1;
        pg8::EpiProj E{PROJ, LOGF, lbl};
        pg8::gemm_phase<pg8::EpiProj, pg8::StaticOrder, true, true>(ldsp, g, S, E);
    }
    GSYNC(); PHT1(1); }
    { PHT0(2);
    {
        PH_BEGIN(); const float* sbn = KIN(4); bf16_t *PROJ = W_BF(WS_PROJ), *UT = W_BF(WS_UT), *MIX = W_BF(WS_MIX); float *LOGF = W_F32(WS_LOGF), *DB = W_F32(WS_U), *DEC = W_F32(WS_SMALL);
        bf16_t* KH = *(bf16_t* const __attribute__((address_space(4)))*)(kp + 104); bf16_t *QT = KH + (size_t)MP * 512, *QB = KH + (size_t)MP * 1024;
        for (int uu = bx; uu < 512 * REP_HL; uu += G) hg_local_unit(((uu >> 6) & 7) * 65 + (uu & 63), false, LOGF, PROJ, KH, QT, QB, DB, UT, DEC, (unsigned*)(ws + 32768), lds);
        for (int uu = bx; uu < 8; uu += G) hg_local_unit(uu * 65 + 64, true, LOGF, PROJ, KH, QT, QB, DB, UT, DEC, (unsigned*)(ws + 32768), lds);
        const int vcu = (G % 8 == 0) ? (bx % 8) * (G / 8) + bx / 8 : bx;
        for (int au = vcu * 8 + wave; au < 4096 * REP_AT; au += G * 8) attn_unit(au & 4095, PROJ, sbn, MIX, (bf16_t*)(lds + 73728 + wave * 4608));
    }
    PHT1(2); }
    { PHT0(3);
    {
        PH_BEGIN(); const bf16_t* __restrict__ UT = W_BF(WS_UT); bf16_t* __restrict__ SP = W_BF(WS_SPREV); const float* __restrict__ DEC = W_F32(WS_SMALL);
        if (bx < 128) {
            if (tid == 0) { unsigned* c = (unsigned*)(ws + 32768) + 64 * (bx >> 4); unsigned sp = 0;
                while (__hip_atomic_load(c, __ATOMIC_RELAXED, __HIP_MEMORY_SCOPE_AGENT) < 64u) { __builtin_amdgcn_s_sleep(2); if (++sp > (1u << 22)) break; }
                __builtin_amdgcn_fence(__ATOMIC_ACQUIRE, "agent"); asm volatile("s_waitcnt vmcnt(0)" ::: "memory"); }
            __syncthreads();
        }
        for (int rb = 0; rb < REP_P2B; ++rb) {
        const int gid = bx * 512 + tid;
        if (gid < 65536) { const int bh = gid >> 13, e2 = gid & 8191, k2 = (2 * e2) & 127;
            float s0 = 0.f, s1 = 0.f;
            for (int c0 = 0; c0 < 64; c0 += 32) {
                unsigned uu[32]; float d0[32], d1[32];
#pragma unroll
                for (int j = 0; j < 32; ++j) { const int unit = bh * 65 + c0 + j; uu[j] = *((const unsigned*)(UT + (size_t)unit * 16384) + e2);
                    const float2 dd = *(const float2*)(DEC + unit * 128 + k2); d0[j] = dd.x; d1[j] = dd.y; }
#pragma unroll
                for (int j = 0; j < 32; ++j) { const int unit = bh * 65 + c0 + j; *((unsigned*)(SP + (size_t)unit * 16384) + e2) = cvtpk(s0, s1);
                    s0 = d0[j] * s0 + bflo(uu[j]); s1 = d1[j] * s1 + bfhi(uu[j]); }
            }
            *((unsigned*)(SP + (size_t)(bh * 65 + 64) * 16384) + e2) = cvtpk(s0, s1);
        }
        }
        {
            const float *w_out = KIN(7), *n2g = KIN(8), *w_gate = KIN(9), *w_up = KIN(10), *w_down = KIN(11);
            bf16_t *Wout_t = W_BF(WS_WOUT), *Wgu_t = W_BF(WS_WGU), *Wdn_t = W_BF(WS_WDN);
            float* scr = (float*)(lds + wave * 16384);
            constexpr int I_OUT = (D / 64) * (D / 32), I_G = (D / 64) * (FF / 32), I_DN = (FF / 64) * (D / 32), NREM = I_OUT + 2 * I_G + I_DN, NIDLE = 3 * 1024;
            const bool idle = bx >= 128; const int idx = (idle ? bx - 128 : bx) * 8 + wave;
            t_run((idle ? 0 : NIDLE) + idx, idle ? NIDLE : NREM, 1024, [&](int it) { int r = it;
                if (r < I_OUT) return TItem{w_out, Wout_t, nullptr, D, D, 0, r}; r -= I_OUT;
                if (r < I_G) return TItem{w_gate, Wgu_t, n2g, D, FF, 1, r}; r -= I_G;
                if (r < I_G) return TItem{w_up, Wgu_t, n2g, D, FF, 2, r}; r -= I_G;
                return TItem{w_down, Wdn_t, nullptr, FF, D, 0, r}; }, scr, lane);
        }
    }
    GSYNC(); PHT1(3); }
    { PHT0(4);
    {
        PH_BEGIN(); const float* hgn = KIN(5); bf16_t *PROJ = W_BF(WS_PROJ), *UT = W_BF(WS_SPREV), *MIX = W_BF(WS_MIX); const float* DB = W_F32(WS_U);
        const bf16_t* KH = *(bf16_t* const __attribute__((address_space(4)))*)(kp + 104); const bf16_t *QT = KH + (size_t)MP * 512, *QB = KH + (size_t)MP * 1024;
        for (int rr = 0; rr < REP_P2C; ++rr) {
            const int bhA = bx >> 6, bhB = 4 + (bx >> 6), cc = (bx & 63) + 1;
            hg_out_stage(bhA, cc, PROJ, UT, lds); hg_out_stage(bhB, cc, PROJ, UT, lds + 69632);
            __syncthreads();
            hg_out_wave(bhA, cc, wave, KH, QT, QB, DB, PROJ, hgn, MIX, lds);
            hg_out_wave(bhB, cc, 7 - wave, KH, QT, QB, DB, PROJ, hgn, MIX, lds + 69632);
            __syncthreads();
        }
    }
    GSYNC(); PHT1(4); }
    { PHT0(5);
    {
        PH_BEGIN(); const float* x = KIN(0); float* out = *(float* const __attribute__((address_space(4)))*)(kp + 104); bf16_t *MIX = W_BF(WS_MIX), *Wout_t = W_BF(WS_WOUT), *H2B = W_BF(WS_LOGF); float* SS2 = W_F32(WS_SMALL + 512 * 1024);
        pg8::Gemm g{MIX, Wout_t, MX, D, D}; pg8::StaticOrder S; S.init(MX, D, G, bx); S.rep = REP_P3;
        pg8::EpiResid E{x, nullptr, H2B, SS2};
        pg8::gemm_phase<pg8::EpiResid, pg8::StaticOrder, false, true>(ldsp, g, S, E);
    }
    GSYNC(); PHT1(5); }
    { PHT0(6);
    {
        PH_BEGIN(); bf16_t *H2B = W_BF(WS_LOGF), *Wgu_t = W_BF(WS_WGU), *HID = W_BF(WS_PROJ); float* SS2 = W_F32(WS_SMALL + 512 * 1024);
        pg8::Gemm g{H2B, Wgu_t, MX, 2 * FF, D}; pg8::StaticOrder S; S.init(MX, 2 * FF, G, bx); S.rep = REP_P4;
        pg8::EpiSwiglu E{HID, SS2};
        pg8::gemm_phase<pg8::EpiSwiglu, pg8::StaticOrder, true, true>(ldsp, g, S, E);
    }
    GSYNC(); PHT1(6); }
    { PHT0(7);
    {
        PH_BEGIN(); const float* fng = KIN(12); float* out = *(float* const __attribute__((address_space(4)))*)(kp + 104); bf16_t *HID = W_BF(WS_PROJ), *Wdn_t = W_BF(WS_WDN); float* SS3 = W_F32(WS_SMALL + 768 * 1024);
        pg8::Gemm g{HID, Wdn_t, MX, D, FF}; pg8::StaticOrder S; S.init(MX, D, G, bx); S.rep = REP_P5;
        pg8::EpiFinal E{W_BF(WS_LOGF), out, SS3, (unsigned*)(ws + 16384), fng};
        pg8::gemm_phase<pg8::EpiFinal, pg8::StaticOrder, false, true>(ldsp, g, S, E);
    }
    PHT1(7); }
}

extern "C" void kernel_launch(void* const* d_in, const int* in_sizes, int n_in, void* d_out, int out_size, void* d_ws, size_t ws_size, hipStream_t stream) {
    static int ready = 0;
    if (!ready) {
        if (n_in != 13 || out_size != MX * D || ws_size < 242 * MiB) { fprintf(stderr, "kernel_launch: unexpected problem shape (n_in %d, out %d, ws %zu)\n", n_in, out_size, ws_size); ready = -1; return; }
        if (hipFuncSetAttribute((const void*)hybrid_fwd, hipFuncAttributeMaxDynamicSharedMemorySize, LDS_BYTES) != hipSuccess) { fprintf(stderr, "kernel_launch: hipFuncSetAttribute failed\n"); ready = -1; return; }
        ready = 1;
    }
    if (ready < 0) return;
    Args a{};
    for (int i = 0; i < 13; ++i) a.in[i] = (const float*)d_in[i];
    a.out = (float*)d_out; a.ws = (unsigned char*)d_ws; a.pad = 0;
    if (hipMemsetAsync(d_ws, 0, 36864, stream) != hipSuccess) { fprintf(stderr, "kernel_launch: memset failed\n"); return; }
    void* args[] = {&a};
    const hipError_t e = hipLaunchCooperativeKernel((const void*)hybrid_fwd, dim3(NWG), dim3(512), args, LDS_BYTES, stream);
    if (e != hipSuccess) fprintf(stderr, "kernel_launch: cooperative launch failed: %s\n", hipGetErrorString(e));
}
```

```cpp
#include <hip/hip_runtime.h>
#include <hip/hip_cooperative_groups.h>
#include <cstdio>
#include <cstdint>
namespace cg = cooperative_groups;
namespace pg8 {
#define PG8_LAS __attribute__((address_space(3)))
typedef unsigned short bf16_t;
typedef short bf16x8 __attribute__((ext_vector_type(8)));
typedef float f32x4 __attribute__((ext_vector_type(4)));
typedef unsigned u32x4 __attribute__((ext_vector_type(4)));
constexpr int BM = 256, BK = 64, HALF = 128, HTB = HALF * BK * 2  , STAGE_BYTES = 8 * HTB, NXCD = 8, WGM = 8;

__host__ __device__ __forceinline__ int lds_byte(int r, int c) { const int st = (r >> 4) * 2 + (c >> 5), rr = r & 15, cc = c & 31, ob = rr * 64 + cc * 2; return st * 1024 + (ob ^ (((ob >> 9) & 1) << 5)); }
__host__ __device__ __forceinline__ void stage_rc(int b, int& R, int& C) { const int st = b / 1024, sb = b % 1024, swz = sb ^ (((sb >> 9) & 1) << 5); R = (st >> 1) * 16 + swz / 64; C = (st & 1) * 32 + (swz % 64) / 2; }
__host__ __device__ __forceinline__ int perm32(int rho) { const int n = rho >> 4, i = rho & 15; return 8 * (i >> 2) + 4 * n + (i & 3); }

struct Unit { int pm, pn; };
struct Gemm { const bf16_t* A; const bf16_t* Bt; int M, N, K; };

struct StaticOrder {
    int nM, nN, nwg, G, c, rep;
    __host__ __device__ void init(int M, int N, int G_, int c_) { nM = M / BM; nN = N / BM; nwg = nM * nN; G = G_; c = c_; rep = 1; }
    __host__ __device__ bool next(int i, Unit& u) const {
        const long L = (long)i * G + c; if (L >= (long)nwg * rep) return false;
        int wgid = (int)(L % nwg); { const int q = nwg / NXCD, r = nwg % NXCD, xcd = wgid % NXCD, off = wgid / NXCD; wgid = (xcd < r ? xcd * (q + 1) : r * (q + 1) + (xcd - r) * q) + off; }
        const int nig = WGM * nN, gid = wgid / nig, fm = gid * WGM, gsz = (nM - fm) < WGM ? (nM - fm) : WGM;
        u.pm = fm + ((wgid % nig) % gsz); u.pn = (wgid % nig) / gsz; return true;
    }
    __device__ __forceinline__ void a_ready(const Unit&) const {}
    __device__ __forceinline__ void done(const Unit&) const {}
};

__device__ __forceinline__ unsigned cvt_pk_bf16(float lo, float hi) { unsigned r; asm volatile("v_cvt_pk_bf16_f32 %0, %1, %2" : "=v"(r) : "v"(lo), "v"(hi)); return r; }
typedef float f32x2 __attribute__((ext_vector_type(2)));
typedef float f32x2_t __attribute__((ext_vector_type(2))); typedef __bf16 bf16x2_t __attribute__((ext_vector_type(2)));
__device__ __forceinline__ unsigned cvtpk(float lo, float hi) { f32x2_t v = {lo, hi}; bf16x2_t b = __builtin_convertvector(v, bf16x2_t); return __builtin_bit_cast(unsigned, b); }
typedef unsigned u32x2 __attribute__((ext_vector_type(2)));

struct EpiProj {
    static constexpr bool PERM = true, AFTER_DRAIN = false;
    bf16_t* proj; float* logf; const float* lbl;
    __device__ __forceinline__ void operator()(const f32x4 (&acc)[2][2][4][2], const Unit& u, int wr, int wc, int fr, int fq) const {
        const int row0 = u.pm * BM + wr * 64 + fr, colt = u.pn * BM, seg = colt >> 9;
        if (seg != 4) {
            const float sc = (seg == 0) ? 0.18033688011112042f : 1.f;
            const int pc = (colt < 2048 ? colt : colt - 512) + wc * 32 + 8 * fq;
#pragma unroll
            for (int ai = 0; ai < 2; ++ai)
#pragma unroll
                for (int m = 0; m < 4; ++m) { bf16_t* rowp = proj + (size_t)(row0 + ai * HALF + m * 16) * 3072 + pc;
#pragma unroll
                    for (int bj = 0; bj < 2; ++bj) { const f32x4 v0 = acc[ai][bj][m][0] * sc, v1 = acc[ai][bj][m][1] * sc;
                        u32x4 w; w.x = cvtpk(v0[0], v0[1]); w.y = cvtpk(v0[2], v0[3]); w.z = cvtpk(v1[0], v1[1]); w.w = cvtpk(v1[2], v1[3]);
                        *(u32x4*)(rowp + bj * HALF) = w; } }
        } else {
            const int c0 = colt - 2048 + wc * 32 + 8 * fq;
            float oml[2][8];
#pragma unroll
            for (int bj = 0; bj < 2; ++bj)
#pragma unroll
                for (int e = 0; e < 8; ++e) { const int c = c0 + bj * HALF + e; oml[bj][e] = 1.0f / (1.0f + __expf(lbl[c] - lbl[512 + c])); }
#pragma unroll
            for (int ai = 0; ai < 2; ++ai)
#pragma unroll
                for (int m = 0; m < 4; ++m) { const int row = row0 + ai * HALF + m * 16; const bool valid = (row % 8320) >= 112; float* rowp = logf + (size_t)row * 512 + c0;
#pragma unroll
                    for (int bj = 0; bj < 2; ++bj)
#pragma unroll
                        for (int n = 0; n < 2; ++n) { f32x4 o;
#pragma unroll
                            for (int e = 0; e < 4; ++e) { const float f = acc[ai][bj][m][n][e]; const float k = oml[bj][4 * n + e] * __builtin_amdgcn_rcpf(1.0f + __expf(f)); o[e] = valid ? __logf(1.0f - k) : 0.f; }
                            *(f32x4*)(rowp + bj * HALF + 4 * n) = o; } }
        }
    }
};

struct EpiResid {
    static constexpr bool PERM = false, AFTER_DRAIN = true;
    const float* base; float* out; bf16_t* outb; float* ss;
    __device__ __forceinline__ void init(f32x4 (&acc)[2][2][4][2], const Unit& u, int wr, int wc, int fr, int fq) const {
        const int col0 = u.pn * BM + wc * 32 + 4 * fq;
#pragma unroll
        for (int ai = 0; ai < 2; ++ai)
#pragma unroll
            for (int m = 0; m < 4; ++m) { const size_t off = (size_t)(u.pm * BM + ai * HALF + wr * 64 + m * 16 + fr) * 1024 + col0;
#pragma unroll
                for (int bj = 0; bj < 2; ++bj)
#pragma unroll
                    for (int n = 0; n < 2; ++n) acc[ai][bj][m][n] = __builtin_nontemporal_load((const f32x4*)(base + off + bj * HALF + n * 16)); }
    }
    __device__ __forceinline__ void fused(f32x4 (&acc)[2][2][4][2], const Unit& u, int wr, int wc, int fr, int fq, PG8_LAS unsigned char* lds, int wid, int lane) const {
        PG8_LAS float* P = (PG8_LAS float*)lds;
        const int col0 = u.pn * BM + wc * 32 + 4 * fq;
#pragma unroll
        for (int ai = 0; ai < 2; ++ai)
#pragma unroll
            for (int m = 0; m < 4; ++m) { const int r = ai * HALF + wr * 64 + m * 16 + fr; const size_t off = (size_t)(u.pm * BM + r) * 1024 + col0; float s = 0.f;
#pragma unroll
                for (int bj = 0; bj < 2; ++bj)
#pragma unroll
                    for (int n = 0; n < 2; ++n) { const f32x4 o = acc[ai][bj][m][n];
                        if (out) *(f32x4*)(out + off + bj * HALF + n * 16) = o;
                        s += (o[0] * o[0] + o[1] * o[1]) + (o[2] * o[2] + o[3] * o[3]);
                        if (outb) { u32x2 w; w.x = cvtpk(o[0], o[1]); w.y = cvtpk(o[2], o[3]); *(u32x2*)(outb + off + bj * HALF + n * 16) = w; } }
                s += __shfl_xor(s, 16); s += __shfl_xor(s, 32);
                if (fq == 0) P[r * 4 + wc] = s; }
        __syncthreads();
        const int tid = wid * 64 + lane;
        if (tid < 256) { const float t = (P[tid * 4 + 0] + P[tid * 4 + 1]) + (P[tid * 4 + 2] + P[tid * 4 + 3]); ss[(size_t)(u.pm * BM + tid) * 4 + u.pn] = t; }
    }
};

struct EpiSwiglu {
    static constexpr bool PERM = true, AFTER_DRAIN = false;
    bf16_t* hid; const float* ss;
    __device__ __forceinline__ void operator()(const f32x4 (&acc)[2][2][4][2], const Unit& u, int wr, int wc, int fr, int fq) const {
        const int row0 = u.pm * BM + wr * 64 + fr, col0 = u.pn * HALF + wc * 32 + 8 * fq;
#pragma unroll
        for (int ai = 0; ai < 2; ++ai)
#pragma unroll
            for (int m = 0; m < 4; ++m) { const int row = row0 + ai * HALF + m * 16; const f32x4 s4 = *(const f32x4*)(ss + (size_t)row * 4);
                const float rstd = __builtin_amdgcn_rsqf(((s4[0] + s4[1]) + (s4[2] + s4[3])) * (1.0f / 1024.0f) + 1e-6f);
                float a[8];
#pragma unroll
                for (int n = 0; n < 2; ++n)
#pragma unroll
                    for (int e = 0; e < 4; ++e) { const float g = acc[ai][0][m][n][e] * rstd, up = acc[ai][1][m][n][e] * rstd; a[4 * n + e] = g * __builtin_amdgcn_rcpf(1.0f + __expf(-g)) * up; }
                u32x4 w; w.x = cvtpk(a[0], a[1]); w.y = cvtpk(a[2], a[3]); w.z = cvtpk(a[4], a[5]); w.w = cvtpk(a[6], a[7]);
                *(u32x4*)(hid + (size_t)row * 2816 + col0) = w; }
    }
};

struct EpiFinal {
    static constexpr bool PERM = false, AFTER_DRAIN = true;
    const bf16_t* base; float* out; float* ss; unsigned* cnt; const float* gf;
    __device__ __forceinline__ void init(f32x4 (&acc)[2][2][4][2], const Unit& u, int wr, int wc, int fr, int fq) const {
        const int col0 = u.pn * BM + wc * 32 + 4 * fq;
#pragma unroll
        for (int ai = 0; ai < 2; ++ai)
#pragma unroll
            for (int m = 0; m < 4; ++m) { const size_t off = (size_t)(u.pm * BM + ai * HALF + wr * 64 + m * 16 + fr) * 1024 + col0;
#pragma unroll
                for (int bj = 0; bj < 2; ++bj)
#pragma unroll
                    for (int n = 0; n < 2; ++n) { const u32x2 bw = __builtin_nontemporal_load((const u32x2*)(base + off + bj * HALF + n * 16));
                        acc[ai][bj][m][n] = (f32x4){__uint_as_float(bw.x << 16), __uint_as_float(bw.x & 0xffff0000u), __uint_as_float(bw.y << 16), __uint_as_float(bw.y & 0xffff0000u)}; } }
    }
    __device__ __forceinline__ void fused(f32x4 (&acc)[2][2][4][2], const Unit& u, int wr, int wc, int fr, int fq, PG8_LAS unsigned char* lds, int wid, int lane) const {
        PG8_LAS float* P = (PG8_LAS float*)lds;
        PG8_LAS float* S = (PG8_LAS float*)(lds + 4096);
        const int col0 = u.pn * BM + wc * 32 + 4 * fq;
#pragma unroll
        for (int ai = 0; ai < 2; ++ai)
#pragma unroll
            for (int m = 0; m < 4; ++m) { const int r = ai * HALF + wr * 64 + m * 16 + fr; float s = 0.f;
#pragma unroll
                for (int bj = 0; bj < 2; ++bj)
#pragma unroll
                    for (int n = 0; n < 2; ++n) { const f32x4 o = acc[ai][bj][m][n]; s += (o[0] * o[0] + o[1] * o[1]) + (o[2] * o[2] + o[3] * o[3]); }
                s += __shfl_xor(s, 16); s += __shfl_xor(s, 32);
                if (fq == 0) P[r * 4 + wc] = s; }
        __syncthreads();
        const int tid = wid * 64 + lane;
        float* slot = ss + (size_t)(u.pm * BM + (tid & 255)) * 4;
        if (tid < 256) { const float t = (P[tid * 4 + 0] + P[tid * 4 + 1]) + (P[tid * 4 + 2] + P[tid * 4 + 3]); __hip_atomic_store(slot + u.pn, t, __ATOMIC_RELAXED, __HIP_MEMORY_SCOPE_AGENT); }
        asm volatile("s_waitcnt vmcnt(0)" ::: "memory");
        unsigned* c = cnt + 64 * u.pm;
        if (lane == 0) __hip_atomic_fetch_add(c, 1u, __ATOMIC_RELAXED, __HIP_MEMORY_SCOPE_AGENT);
        if (wid == 0) {
            unsigned sp = 0;
            while ((unsigned)__builtin_amdgcn_readfirstlane(__hip_atomic_load(c, __ATOMIC_RELAXED, __HIP_MEMORY_SCOPE_AGENT)) < 32u) { __builtin_amdgcn_s_sleep(2); if (++sp > (1u << 22)) break; }
            __builtin_amdgcn_fence(__ATOMIC_ACQUIRE, "agent");
        }
        asm volatile("s_waitcnt vmcnt(0) lgkmcnt(0)" ::: "memory");
        __syncthreads();
        if (tid < 256) { float t4[4];
#pragma unroll
            for (int t = 0; t < 4; ++t) t4[t] = __hip_atomic_load(slot + t, __ATOMIC_RELAXED, __HIP_MEMORY_SCOPE_AGENT);
            S[tid] = 1.0f / sqrtf(((t4[0] + t4[1]) + (t4[2] + t4[3])) * (1.0f / 1024.0f) + 1e-6f); }
        __syncthreads();
#pragma unroll
        for (int ai = 0; ai < 2; ++ai)
#pragma unroll
            for (int m = 0; m < 4; ++m) { const int r = ai * HALF + wr * 64 + m * 16 + fr; const float rs = S[r]; const size_t off = (size_t)(u.pm * BM + r) * 1024 + col0;
#pragma unroll
                for (int bj = 0; bj < 2; ++bj)
#pragma unroll
                    for (int n = 0; n < 2; ++n) { const f32x4 g4 = *(const f32x4*)(gf + col0 + bj * HALF + n * 16); __builtin_nontemporal_store(acc[ai][bj][m][n] * rs * g4, (f32x4*)(out + off + bj * HALF + n * 16)); } }
    }
};
template <class Epi, class Sched, bool ALIGN_EPI = false, bool SP2 = false>
__device__ __forceinline__ void gemm_phase(PG8_LAS unsigned char* lds, const Gemm g, const Sched& S, const Epi& E) {
    int tid_ = threadIdx.x; asm volatile("" : "+v"(tid_));
    const int tid = tid_, wid = __builtin_amdgcn_readfirstlane(tid >> 6), lane = tid & 63, wr = wid >> 2, wc = wid & 3, fr = lane & 15, fq = lane >> 4;
    const int K = g.K, nt = K / BK;
    unsigned voffA[2], voffB[2];
#pragma unroll
    for (int i = 0; i < 2; ++i) { int R, C; stage_rc(tid * 16 + i * 8192, R, C); const int Rb = Epi::PERM ? ((R & ~31) + perm32(R & 31)) : R;
        voffA[i] = (unsigned)(R * K + C) * 2u; voffB[i] = (unsigned)(Rb * K + C) * 2u; }
    const size_t kstep = (size_t)(BK * 2);
    const size_t hstep = (size_t)HALF * K * 2;
    const size_t tstep = 2 * hstep;
    const unsigned ldsw = (unsigned)wid * 1024u;
    const int aoff = lds_byte(wr * 64 + fr, fq * 8), boff = lds_byte(wc * 32 + fr, fq * 8);
#define PG8_SA(b, h) (((b) * 2 + (h)) * HTB)
#define PG8_SB(b, h) ((4 + (b) * 2 + (h)) * HTB)
#define PG8_STAGE(bufoff, gbase, voff) do { _Pragma("unroll") for (int _i = 0; _i < 2; ++_i) \
        __builtin_amdgcn_global_load_lds((const unsigned*)((const char*)(gbase) + (voff)[_i]), (PG8_LAS unsigned*)(lds + (bufoff) + ldsw + _i * 8192), 16, 0, 0); } while (0)
#define PG8_LDA(dst, b, h) do { _Pragma("unroll") for (int m = 0; m < 4; ++m) _Pragma("unroll") for (int k = 0; k < 2; ++k) dst[m][k] = *(const PG8_LAS bf16x8*)(lds + PG8_SA(b, h) + aoff + m * 2048 + k * 1024); } while (0)
#define PG8_LDB(dst, b, h) do { _Pragma("unroll") for (int n = 0; n < 2; ++n) _Pragma("unroll") for (int k = 0; k < 2; ++k) dst[n][k] = *(const PG8_LAS bf16x8*)(lds + PG8_SB(b, h) + boff + n * 2048 + k * 1024); } while (0)
#define PG8_MMA(ai, bj, At, Bt) do { __builtin_amdgcn_s_setprio(1); _Pragma("unroll") for (int m = 0; m < 4; ++m) _Pragma("unroll") for (int n = 0; n < 2; ++n) _Pragma("unroll") for (int k = 0; k < 2; ++k) \
        acc[ai][bj][m][n] = __builtin_amdgcn_mfma_f32_16x16x32_bf16(Bt[n][k], At[m][k], acc[ai][bj][m][n], 0, 0, 0); __builtin_amdgcn_s_setprio(0); } while (0)
#define PG8_WAIT_V(n) asm volatile("s_waitcnt vmcnt(" #n ")" ::: "memory")
#define PG8_WAIT_L(n) asm volatile("s_waitcnt lgkmcnt(" #n ")" ::: "memory")
#define PG8_BAR __builtin_amdgcn_s_barrier()
#define PG8_SCHED __builtin_amdgcn_sched_barrier(0)
    Unit cur, nxt; int ui = 0;
    if (!S.next(0, cur)) return;
    f32x4 acc[2][2][4][2];
    if constexpr (Epi::AFTER_DRAIN) E.init(acc, cur, wr, wc, fr, fq);
    else {
#pragma unroll
    for (int a = 0; a < 2; ++a)
#pragma unroll
        for (int b = 0; b < 2; ++b)
#pragma unroll
            for (int m = 0; m < 4; ++m)
#pragma unroll
                for (int n = 0; n < 2; ++n) acc[a][b][m][n] = (f32x4){0.f, 0.f, 0.f, 0.f};
    }
    bf16x8 At[4][2], B0[2][2], B1[2][2];
    const char* cA = (const char*)g.A + (size_t)cur.pm * tstep; const char* cB = (const char*)g.Bt + (size_t)cur.pn * tstep;
    S.a_ready(cur);
    if constexpr (SP2) {
        PG8_STAGE(PG8_SB(0, 0), cB, voffB); PG8_STAGE(PG8_SB(0, 1), cB + hstep, voffB); PG8_STAGE(PG8_SA(0, 0), cA, voffA); PG8_STAGE(PG8_SA(0, 1), cA + hstep, voffA);
        if (wr == 1) PG8_BAR;
        PG8_WAIT_V(2); PG8_BAR;
        PG8_STAGE(PG8_SB(1, 0), cB + kstep, voffB); PG8_STAGE(PG8_SA(1, 0), cA + kstep, voffA); PG8_STAGE(PG8_SB(1, 1), cB + hstep + kstep, voffB);
        PG8_WAIT_V(6); PG8_BAR;
    } else {
        PG8_STAGE(PG8_SB(0, 0), cB, voffB); PG8_STAGE(PG8_SA(0, 0), cA, voffA); PG8_STAGE(PG8_SB(0, 1), cB + hstep, voffB); PG8_STAGE(PG8_SA(0, 1), cA + hstep, voffA);
        if (wr == 1) PG8_BAR;
        PG8_WAIT_V(4); PG8_BAR;
        PG8_STAGE(PG8_SB(1, 0), cB + kstep, voffB); PG8_STAGE(PG8_SA(1, 0), cA + kstep, voffA); PG8_STAGE(PG8_SB(1, 1), cB + hstep + kstep, voffB);
        PG8_WAIT_V(6); PG8_BAR;
    }
    for (;;) {
        const bool has_next = S.next(ui + 1, nxt);
        const char* nA = has_next ? (const char*)g.A + (size_t)nxt.pm * tstep : cA; const char* nB = has_next ? (const char*)g.Bt + (size_t)nxt.pn * tstep : cB;
        for (int t = 0; t < nt; t += 2) {
            const bool last = (t == nt - 2);
            const char* a1 = cA + (size_t)(t + 1) * kstep;
            const char* a2 = last ? nA : cA + (size_t)(t + 2) * kstep; const char* b2 = last ? nB : cB + (size_t)(t + 2) * kstep;
            const char* a3 = a2 + kstep; const char* b3 = b2 + kstep;
            if (last && has_next) S.a_ready(nxt);
            if constexpr (SP2) {
            PG8_LDB(B0, 0, 0); PG8_LDB(B1, 0, 1); PG8_SCHED; PG8_LDA(At, 0, 0); PG8_STAGE(PG8_SA(1, 1), a1 + hstep, voffA);
            PG8_WAIT_V(8); PG8_WAIT_L(0); PG8_BAR; PG8_MMA(0, 0, At, B0); PG8_MMA(0, 1, At, B1); PG8_BAR; PG8_SCHED;
            PG8_LDA(At, 0, 1); PG8_STAGE(PG8_SB(0, 0), b2, voffB); PG8_STAGE(PG8_SB(0, 1), b2 + hstep, voffB); PG8_STAGE(PG8_SA(0, 0), a2, voffA);
            PG8_WAIT_V(8); PG8_WAIT_L(0); PG8_BAR; PG8_MMA(1, 0, At, B0); PG8_MMA(1, 1, At, B1); PG8_BAR; PG8_SCHED;
            PG8_LDB(B0, 1, 0); PG8_LDB(B1, 1, 1); PG8_SCHED; PG8_LDA(At, 1, 0); PG8_STAGE(PG8_SA(0, 1), a2 + hstep, voffA);
            PG8_WAIT_V(8); PG8_WAIT_L(0); PG8_BAR; PG8_MMA(0, 0, At, B0); PG8_MMA(0, 1, At, B1); PG8_BAR; PG8_SCHED;
            PG8_LDA(At, 1, 1); PG8_STAGE(PG8_SB(1, 0), b3, voffB); PG8_STAGE(PG8_SB(1, 1), b3 + hstep, voffB); PG8_STAGE(PG8_SA(1, 0), a3, voffA);
            PG8_WAIT_V(8); PG8_WAIT_L(0); PG8_BAR; PG8_MMA(1, 0, At, B0); PG8_MMA(1, 1, At, B1); PG8_BAR; PG8_SCHED;
            } else {
            PG8_LDB(B0, 0, 0); PG8_SCHED; PG8_LDA(At, 0, 0); PG8_STAGE(PG8_SA(1, 1), a1 + hstep, voffA);
            PG8_WAIT_L(8); PG8_BAR; PG8_WAIT_L(0); PG8_MMA(0, 0, At, B0); PG8_BAR; PG8_SCHED;
            PG8_LDB(B1, 0, 1); PG8_STAGE(PG8_SB(0, 0), b2, voffB);
            PG8_BAR; PG8_WAIT_L(0); PG8_MMA(0, 1, At, B1); PG8_BAR;
            PG8_LDA(At, 0, 1); PG8_STAGE(PG8_SA(0, 0), a2, voffA);
            PG8_BAR; PG8_WAIT_L(0); PG8_MMA(1, 0, At, B0); PG8_BAR; PG8_SCHED;
            PG8_STAGE(PG8_SB(0, 1), b2 + hstep, voffB);
            PG8_WAIT_V(6); PG8_BAR; PG8_MMA(1, 1, At, B1); PG8_BAR;
            PG8_LDB(B0, 1, 0); PG8_SCHED; PG8_LDA(At, 1, 0); PG8_STAGE(PG8_SA(0, 1), a2 + hstep, voffA);
            PG8_WAIT_L(8); PG8_BAR; PG8_WAIT_L(0); PG8_MMA(0, 0, At, B0); PG8_BAR; PG8_SCHED;
            PG8_LDB(B1, 1, 1); PG8_STAGE(PG8_SB(1, 0), b3, voffB);
            PG8_BAR; PG8_WAIT_L(0); PG8_MMA(0, 1, At, B1); PG8_BAR;
            PG8_LDA(At, 1, 1); PG8_STAGE(PG8_SA(1, 0), a3, voffA);
            PG8_BAR; PG8_WAIT_L(0); PG8_MMA(1, 0, At, B0); PG8_BAR; PG8_SCHED;
            PG8_STAGE(PG8_SB(1, 1), b3 + hstep, voffB);
            PG8_WAIT_V(6); PG8_BAR; PG8_MMA(1, 1, At, B1); PG8_BAR;
            }
        }
        if constexpr (ALIGN_EPI) { if (wr == 0) PG8_BAR; }
        if constexpr (!Epi::AFTER_DRAIN) { E(acc, cur, wr, wc, fr, fq); S.done(cur); }
        if (!has_next) break;
#pragma unroll
        for (int a = 0; a < 2; ++a)
#pragma unroll
            for (int b = 0; b < 2; ++b)
#pragma unroll
                for (int m = 0; m < 4; ++m)
#pragma unroll
                    for (int n = 0; n < 2; ++n) acc[a][b][m][n] = (f32x4){0.f, 0.f, 0.f, 0.f};
        cur = nxt; cA = nA; cB = nB; ++ui;
        if constexpr (ALIGN_EPI) { if (wr == 1) PG8_BAR; }
    }
    PG8_WAIT_V(0);
    if constexpr (!ALIGN_EPI) { if (wr == 0) PG8_BAR; }
    PG8_BAR;
    if constexpr (Epi::AFTER_DRAIN) { E.fused(acc, cur, wr, wc, fr, fq, lds, wid, lane); S.done(cur); }
#undef PG8_SA
#undef PG8_SB
#undef PG8_STAGE
#undef PG8_LDA
#undef PG8_LDB
#undef PG8_MMA
#undef PG8_WAIT_V
#undef PG8_WAIT_L
#undef PG8_BAR
#undef PG8_SCHED
}
}

using pg8::bf16_t; using pg8::bf16x8; using pg8::f32x4; using pg8::u32x4; using pg8::u32x2; using pg8::cvtpk;
typedef float f32x16 __attribute__((ext_vector_type(16)));
constexpr int D = 1024, SEQ = 8192, LP = 8320, NB = 2, MP = NB * LP, MX = NB * SEQ, INW = 3584, PW = 3072, FF = 2816;
constexpr float EPS = 1e-6f;
constexpr size_t MiB = 1u << 20;
constexpr size_t WS_WIN = 1 * MiB, WS_WOUT = 8 * MiB, WS_WGU = 10 * MiB, WS_WDN = 21 * MiB;
constexpr size_t WS_U = 27 * MiB;
constexpr size_t WS_LOGF = 60 * MiB;
constexpr size_t WS_UT = 93 * MiB;
constexpr size_t WS_SPREV = 31 * MiB;
constexpr size_t WS_MIX = 110 * MiB;
constexpr size_t WS_SMALL = 142 * MiB;
constexpr size_t WS_PROJ = 144 * MiB;
constexpr int LDS_BYTES = 147456;
constexpr int NWG = 256;

__device__ __forceinline__ float bflo(unsigned w) { return __uint_as_float(w << 16); }
__device__ __forceinline__ float bfhi(unsigned w) { return __uint_as_float(w & 0xffff0000u); }
__device__ __forceinline__ float wave_sum(float v) {
#pragma unroll
    for (int o = 1; o < 64; o <<= 1) v += __shfl_xor(v, o);
    return v;
}
#define LDS_WAIT() asm volatile("s_waitcnt lgkmcnt(0)" ::: "memory")

struct TItem { const float* W; bf16_t* WT; const float* gk; int K, N, mode, item; };
__device__ __forceinline__ void t_load(const TItem& t, float (&wv)[32], int lane) {
    const int nblk = t.N / 32, kb = t.item / nblk, nb = t.item % nblk, k0 = 64 * kb, n0 = 32 * nb;
#pragma unroll
    for (int i = 0; i < 32; ++i) { const int kk = 2 * i + (lane >> 5); wv[i] = __builtin_nontemporal_load(t.W + (size_t)(k0 + kk) * t.N + n0 + (lane & 31)); }
}
__device__ __forceinline__ void t_finish(const TItem& t, const float (&wv)[32], float* scr, int lane) {
    const int nblk = t.N / 32, kb = t.item / nblk, nb = t.item % nblk, k0 = 64 * kb, n0 = 32 * nb;
#pragma unroll
    for (int i = 0; i < 32; ++i) { const int kk = 2 * i + (lane >> 5); float w = wv[i]; if (t.gk) w *= t.gk[k0 + kk]; scr[kk * 33 + (lane & 31)] = w; }
    LDS_WAIT();
    const int c = lane & 7;
#pragma unroll
    for (int j = 0; j < 4; ++j) { const int n = (lane >> 3) + 8 * j; const float* s = scr + (8 * c) * 33 + n;
        u32x4 o; o.x = cvtpk(s[0 * 33], s[1 * 33]); o.y = cvtpk(s[2 * 33], s[3 * 33]); o.z = cvtpk(s[4 * 33], s[5 * 33]); o.w = cvtpk(s[6 * 33], s[7 * 33]);
        const int nn = n0 + n; const int drow = (t.mode == 0) ? nn : (((nn >> 7) << 8) + (nn & 127) + (t.mode == 2 ? 128 : 0));
        *(u32x4*)(t.WT + (size_t)drow * t.K + k0 + 8 * c) = o; }
    LDS_WAIT();
}
template <class MK> __device__ __forceinline__ void t_run(int first, int end, int step, const MK& mk, float* scr, int lane) {
    if (first >= end) return;
    float wa[32], wb[32]; TItem cur = mk(first); t_load(cur, wa, lane);
    for (int it = first; it < end; it += step) {
        const int nx = it + step; TItem nxt = cur;
        if (nx < end) { nxt = mk(nx); t_load(nxt, wb, lane); }
        t_finish(cur, wa, scr, lane);
        cur = nxt;
#pragma unroll
        for (int i = 0; i < 32; ++i) wa[i] = wb[i];
    }
}
__device__ __forceinline__ void u_load4(int m0, const float* x, const float* meta, f32x4 (&v)[4][4], int lane) {
#pragma unroll
    for (int rr = 0; rr < 4; ++rr) { const int m = m0 + rr, b = m / LP, pos = m % LP;
        const float* src = pos < 112 ? nullptr : (pos < 128 ? meta + (size_t)(pos - 112) * D : x + ((size_t)b * SEQ + pos - 128) * D);
#pragma unroll
        for (int j = 0; j < 4; ++j) v[rr][j] = src ? __builtin_nontemporal_load((const f32x4*)src + lane + 64 * j) : (f32x4){0.f, 0.f, 0.f, 0.f}; }
}
__device__ __forceinline__ void u_finish4(int m0, const f32x4 (&v)[4][4], const float* g, bf16_t* U, int lane) {
    float s[4];
#pragma unroll
    for (int rr = 0; rr < 4; ++rr) { float t = 0.f;
#pragma unroll
        for (int j = 0; j < 4; ++j) t += (v[rr][j][0] * v[rr][j][0] + v[rr][j][1] * v[rr][j][1]) + (v[rr][j][2] * v[rr][j][2] + v[rr][j][3] * v[rr][j][3]);
        s[rr] = t; }
#pragma unroll
    for (int o = 1; o < 64; o <<= 1) {
#pragma unroll
        for (int rr = 0; rr < 4; ++rr) s[rr] += __shfl_xor(s[rr], o); }
#pragma unroll
    for (int rr = 0; rr < 4; ++rr) { const float rstd = __builtin_amdgcn_rsqf(s[rr] * (1.0f / D) + EPS); bf16_t* orow = U + (size_t)(m0 + rr) * D;
#pragma unroll
        for (int j = 0; j < 4; ++j) { const f32x4 g4 = ((const f32x4*)g)[lane + 64 * j]; const f32x4 o = v[rr][j] * rstd * g4;
            u32x2 w; w.x = cvtpk(o[0], o[1]); w.y = cvtpk(o[2], o[3]); ((u32x2*)orow)[lane + 64 * j] = w; } }
}

__device__ __forceinline__ void stage_vT(const bf16_t* PROJ, size_t m0, int h, bf16_t* vT) {
    const int tid = threadIdx.x;
#pragma unroll
    for (int ii = 0; ii < 2; ++ii) { const int it = tid + 512 * ii, sp = it & 63, vc = it >> 6;
        const bf16_t* src = PROJ + (m0 + 2 * sp) * PW + 2048 + h * 128 + vc * 8;
        const u32x4 d0 = *(const u32x4*)src, d1 = *(const u32x4*)(src + PW);
#pragma unroll
        for (int j = 0; j < 4; ++j) { *(unsigned*)(vT + (vc * 8 + 2 * j) * 136 + 2 * sp) = (d0[j] & 0xffffu) | (d1[j] << 16);
            *(unsigned*)(vT + (vc * 8 + 2 * j + 1) * 136 + 2 * sp) = (d0[j] >> 16) | (d1[j] & 0xffff0000u); } }
}
__device__ __forceinline__ void st8_wt(void* p, u32x2 v) { __hip_atomic_store((unsigned long long*)p, (unsigned long long)v.x | ((unsigned long long)v.y << 32), __ATOMIC_RELAXED, __HIP_MEMORY_SCOPE_AGENT); }
__device__ __forceinline__ f32x4 exp4(f32x4 v) { return (f32x4){__expf(v[0]), __expf(v[1]), __expf(v[2]), __expf(v[3])}; }
__device__ __forceinline__ void hg_local_unit(int unit, bool light, const float* LOGF, const bf16_t* PROJ, bf16_t* KH, bf16_t* QT, bf16_t* QB, float* DB, bf16_t* UT, float* DEC, unsigned* done_cnt, unsigned char* lds) {
    const int tid = threadIdx.x, lane = tid & 63, w = __builtin_amdgcn_readfirstlane(tid >> 6);
    const int bh = unit / 65, c = unit % 65, b = bh >> 2, h = bh & 3;
    const size_t m0 = (size_t)b * LP + (size_t)c * 128;
    bf16_t* kT = (bf16_t*)lds;
    bf16_t* vT = (bf16_t*)(lds + 34816);
    float* tot = (float*)(lds + 69632);
    const int kq = tid & 31, rg = tid >> 5;
    if (!light) stage_vT(PROJ, m0, h, vT);
    const size_t rbase = (m0 + rg * 8) * 512 + h * 128 + 4 * kq;
    f32x4 pre[8], kk[8]; u32x2 qw[8]; f32x4 run = (f32x4){0.f, 0.f, 0.f, 0.f};
#pragma unroll
    for (int i = 0; i < 8; ++i) pre[i] = __builtin_nontemporal_load((const f32x4*)(LOGF + rbase + (size_t)i * 512));
#pragma unroll
    for (int i = 0; i < 8; ++i) qw[i] = *(const u32x2*)(PROJ + (m0 + rg * 8 + i) * PW + 1536 + h * 128 + 4 * kq);
#pragma unroll
    for (int i = 0; i < 8; ++i) { const f32x4 lf = pre[i]; run += lf; pre[i] = run; kk[i] = 1.0f - exp4(lf); }
    *(f32x4*)(tot + rg * 128 + 4 * kq) = run;
    __syncthreads();
    f32x4 off = (f32x4){0.f, 0.f, 0.f, 0.f}, Bj = off, blast = off; const int g0 = rg & ~1;
#pragma unroll
    for (int g = 0; g < 16; ++g) { const f32x4 t = *(const f32x4*)(tot + g * 128 + 4 * kq); if (g < rg) off += t; if (g < g0) Bj += t; blast += t; }
    const f32x4 Ej = Bj + *(const f32x4*)(tot + g0 * 128 + 4 * kq) + *(const f32x4*)(tot + (g0 + 1) * 128 + 4 * kq);
    const f32x4 cE = exp4(blast - Ej);
    u32x4 ktw[4];
#pragma unroll
    for (int i = 0; i < 8; i += 2) {
        const f32x4 b0 = off + pre[i], b1 = off + pre[i + 1];
        const f32x4 kh0 = kk[i] * exp4(Ej - b0), kh1 = kk[i + 1] * exp4(Ej - b1);
        const f32x4 q0 = (f32x4){bflo(qw[i].x), bfhi(qw[i].x), bflo(qw[i].y), bfhi(qw[i].y)}, q1 = (f32x4){bflo(qw[i + 1].x), bfhi(qw[i + 1].x), bflo(qw[i + 1].y), bfhi(qw[i + 1].y)};
        const f32x4 qt0 = q0 * exp4(b0 - Bj), qt1 = q1 * exp4(b1 - Bj), qb0 = q0 * exp4(b0), qb1 = q1 * exp4(b1);
        u32x2 s;
        s.x = cvtpk(kh0[0], kh0[1]); s.y = cvtpk(kh0[2], kh0[3]); st8_wt(KH + rbase + (size_t)i * 512, s);
        s.x = cvtpk(kh1[0], kh1[1]); s.y = cvtpk(kh1[2], kh1[3]); st8_wt(KH + rbase + (size_t)(i + 1) * 512, s);
        s.x = cvtpk(qt0[0], qt0[1]); s.y = cvtpk(qt0[2], qt0[3]); st8_wt(QT + rbase + (size_t)i * 512, s);
        s.x = cvtpk(qt1[0], qt1[1]); s.y = cvtpk(qt1[2], qt1[3]); st8_wt(QT + rbase + (size_t)(i + 1) * 512, s);
        s.x = cvtpk(qb0[0], qb0[1]); s.y = cvtpk(qb0[2], qb0[3]); st8_wt(QB + rbase + (size_t)i * 512, s);
        s.x = cvtpk(qb1[0], qb1[1]); s.y = cvtpk(qb1[2], qb1[3]); st8_wt(QB + rbase + (size_t)(i + 1) * 512, s);
        const f32x4 u0 = kh0 * cE, u1 = kh1 * cE;
#pragma unroll
        for (int cc = 0; cc < 4; ++cc) ktw[cc][i >> 1] = cvtpk(u0[cc], u1[cc]);
    }
#pragma unroll
    for (int cc = 0; cc < 4; ++cc) *(u32x4*)(kT + (4 * kq + cc) * 136 + rg * 8) = ktw[cc];
    if ((rg & 1) == 0) { const f32x4 dv = exp4(Ej - Bj); float* dp = DB + (size_t)unit * 1024 + (rg >> 1) * 128 + 4 * kq;
        st8_wt(dp, (u32x2){__float_as_uint(dv[0]), __float_as_uint(dv[1])}); st8_wt(dp + 2, (u32x2){__float_as_uint(dv[2]), __float_as_uint(dv[3])}); }
    if (rg == 0) { const f32x4 dv = exp4(blast); unsigned long long* dp = (unsigned long long*)(DEC + unit * 128 + 4 * kq);
        __hip_atomic_store(dp, (unsigned long long)__float_as_uint(dv[0]) | ((unsigned long long)__float_as_uint(dv[1]) << 32), __ATOMIC_RELAXED, __HIP_MEMORY_SCOPE_AGENT);
        __hip_atomic_store(dp + 1, (unsigned long long)__float_as_uint(dv[2]) | ((unsigned long long)__float_as_uint(dv[3]) << 32), __ATOMIC_RELAXED, __HIP_MEMORY_SCOPE_AGENT); }
    __syncthreads();
    if (light) {
        asm volatile("s_waitcnt vmcnt(0)" ::: "memory"); __syncthreads();
        if (tid == 0) __hip_atomic_fetch_add(done_cnt + 64 * bh, 1u, __ATOMIC_RELAXED, __HIP_MEMORY_SCOPE_AGENT);
        return; }
    const int r = lane & 15, quad = lane >> 4;
    f32x4 acc[8];
#pragma unroll
    for (int vt = 0; vt < 8; ++vt) acc[vt] = (f32x4){0.f, 0.f, 0.f, 0.f};
#pragma unroll
    for (int ss = 0; ss < 4; ++ss) { const bf16x8 a = *(const bf16x8*)(kT + (16 * w + r) * 136 + 32 * ss + quad * 8);
#pragma unroll
        for (int vt = 0; vt < 8; ++vt) { const bf16x8 bb = *(const bf16x8*)(vT + (16 * vt + r) * 136 + 32 * ss + quad * 8); acc[vt] = __builtin_amdgcn_mfma_f32_16x16x32_bf16(a, bb, acc[vt], 0, 0, 0); } }
#pragma unroll
    for (int vt = 0; vt < 8; ++vt) { u32x2 o; o.x = cvtpk(acc[vt][0], acc[vt][1]); o.y = cvtpk(acc[vt][2], acc[vt][3]);
        __hip_atomic_store((unsigned long long*)(UT + (size_t)unit * 16384 + (16 * vt + r) * 128 + 16 * w + quad * 4), (unsigned long long)o.x | ((unsigned long long)o.y << 32), __ATOMIC_RELAXED, __HIP_MEMORY_SCOPE_AGENT); }
    asm volatile("s_waitcnt vmcnt(0)" ::: "memory");
    __syncthreads();
    if (tid == 0) __hip_atomic_fetch_add(done_cnt + 64 * bh, 1u, __ATOMIC_RELAXED, __HIP_MEMORY_SCOPE_AGENT);
}

__device__ __forceinline__ void attn_unit(int au, const bf16_t* PROJ, const float* sbn, bf16_t* MIX, bf16_t* vl) {
    const int lane = threadIdx.x & 63, r32 = lane & 31, hh = lane >> 5;
    const int qt = au & 255, head = (au >> 8) & 7, b = au >> 11;
    const int q0 = 128 + 32 * qt; const size_t mb = (size_t)b * LP;
    const bf16_t* Qp = PROJ + (mb + q0 + r32) * PW + head * 64 + 8 * hh;
    bf16x8 qf[4];
#pragma unroll
    for (int ds = 0; ds < 4; ++ds) qf[ds] = *(const bf16x8*)(Qp + 16 * ds);
    f32x16 o0, o1;
#pragma unroll
    for (int i = 0; i < 16; ++i) { o0[i] = 0.f; o1[i] = 0.f; }
    float carry = 0.f; const int qpos = q0 + r32;
    const int prow = lane >> 3, pcol = (lane & 7) * 8;
    const bf16_t* Kbase = PROJ + (mb + r32) * PW + 512 + head * 64 + 8 * hh;
    const bf16_t* Vbase = PROJ + (mb + prow) * PW + 1024 + head * 64 + pcol;
    int kt = q0 >> 5;
    bf16x8 kn[4]; u32x4 vn[4];
#pragma unroll
    for (int ds = 0; ds < 4; ++ds) kn[ds] = *(const bf16x8*)(Kbase + (size_t)(32 * kt) * PW + 16 * ds);
#pragma unroll
    for (int i = 0; i < 4; ++i) vn[i] = *(const u32x4*)(Vbase + (size_t)(32 * kt + 8 * i) * PW);
    for (;;) {
        const int kv0 = 32 * kt; const bool more = kt > 3;
        bf16x8 kf[4];
#pragma unroll
        for (int ds = 0; ds < 4; ++ds) kf[ds] = kn[ds];
#pragma unroll
        for (int i = 0; i < 4; ++i) *(u32x4*)(vl + (prow + 8 * i) * 72 + pcol) = vn[i];
        asm volatile("" ::: "memory");
        if (more) {
#pragma unroll
            for (int ds = 0; ds < 4; ++ds) kn[ds] = *(const bf16x8*)(Kbase + (size_t)(kv0 - 32) * PW + 16 * ds);
#pragma unroll
            for (int i = 0; i < 4; ++i) vn[i] = *(const u32x4*)(Vbase + (size_t)(kv0 - 32 + 8 * i) * PW);
        }
        f32x16 x;
#pragma unroll
        for (int i = 0; i < 16; ++i) x[i] = 0.f;
#pragma unroll
        for (int ds = 0; ds < 4; ++ds) x = __builtin_amdgcn_mfma_f32_32x32x16_bf16(kf[ds], qf[ds], x, 0, 0, 0);
        float be[16], om[16];
        const bool edge = (kt == (q0 >> 5)) || (kt == 3);
#pragma unroll
        for (int i = 0; i < 16; ++i) { const float zp = x[i]; const float u = __builtin_amdgcn_exp2f(-fabsf(zp)); const float s = __builtin_amdgcn_rcpf(1.0f + u), us = u * s;
            be[i] = zp > 0.f ? s : us; om[i] = zp > 0.f ? us : s; }
        if (edge) {
#pragma unroll
            for (int i = 0; i < 16; ++i) { const int kv = kv0 + (i & 3) + 8 * (i >> 2) + 4 * hh; const bool vis = (kv < qpos) && (kv >= 112); be[i] = vis ? be[i] : 0.f; om[i] = vis ? om[i] : 1.0f; } }
        float gp[4], pp[4], T[4]; float run = 1.0f;
#pragma unroll
        for (int g = 0; g < 4; ++g) gp[g] = (om[4 * g] * om[4 * g + 1]) * (om[4 * g + 2] * om[4 * g + 3]);
#pragma unroll
        for (int g = 0; g < 4; ++g) pp[g] = __shfl_xor(gp[g], 32);
#pragma unroll
        for (int g = 3; g >= 0; --g) { T[g] = hh == 0 ? run * pp[g] : run; run *= gp[g] * pp[g]; }
        const float C = __builtin_amdgcn_exp2f(carry);
        float wv[16];
#pragma unroll
        for (int g = 0; g < 4; ++g) { float a = C * T[g];
#pragma unroll
            for (int e = 3; e >= 0; --e) { const int i = 4 * g + e; wv[i] = be[i] * a; a *= om[i]; } }
        carry += __builtin_amdgcn_logf(run);
        bf16x8 xs[2];
#pragma unroll
        for (int s = 0; s < 2; ++s) { u32x4 pw; pw.x = cvtpk(wv[8 * s], wv[8 * s + 1]); pw.y = cvtpk(wv[8 * s + 2], wv[8 * s + 3]); pw.z = cvtpk(wv[8 * s + 4], wv[8 * s + 5]); pw.w = cvtpk(wv[8 * s + 6], wv[8 * s + 7]);
            xs[s] = __builtin_bit_cast(bf16x8, pw); }
        const bf16_t* vp = vl + (4 * hh) * 72 + r32;
#pragma unroll
        for (int s = 0; s < 2; ++s) {
            bf16x8 va, vb;
#pragma unroll
            for (int j = 0; j < 8; ++j) { const bf16_t* p = vp + (16 * s + 8 * (j >> 2) + (j & 3)) * 72; va[j] = (short)p[0]; vb[j] = (short)p[32]; }
            o0 = __builtin_amdgcn_mfma_f32_32x32x16_bf16(va, xs[s], o0, 0, 0, 0);
            o1 = __builtin_amdgcn_mfma_f32_32x32x16_bf16(vb, xs[s], o1, 0, 0, 0);
        }
        asm volatile("" ::: "memory");
        if (!more || __all(carry < -152.0f)) break;
        --kt;
    }
    float ss = 0.f;
#pragma unroll
    for (int i = 0; i < 16; ++i) ss += o0[i] * o0[i] + o1[i] * o1[i];
    ss += __shfl_xor(ss, 32);
    const float rstd = 1.0f / sqrtf(ss * (1.0f / 64.0f) + EPS);
    bf16_t* orow = MIX + ((size_t)b * SEQ + q0 - 128 + r32) * D + head * 64;
#pragma unroll
    for (int g = 0; g < 4; ++g) { const int d0 = 8 * g + 4 * hh;
        const f32x4 g0 = *(const f32x4*)(sbn + head * 64 + d0), g1 = *(const f32x4*)(sbn + head * 64 + 32 + d0);
        u32x2 w0, w1;
        w0.x = cvtpk(o0[4 * g] * rstd * g0[0], o0[4 * g + 1] * rstd * g0[1]); w0.y = cvtpk(o0[4 * g + 2] * rstd * g0[2], o0[4 * g + 3] * rstd * g0[3]);
        w1.x = cvtpk(o1[4 * g] * rstd * g1[0], o1[4 * g + 1] * rstd * g1[1]); w1.y = cvtpk(o1[4 * g + 2] * rstd * g1[2], o1[4 * g + 3] * rstd * g1[3]);
        *(u32x2*)(orow + d0) = w0; *(u32x2*)(orow + 32 + d0) = w1; }
}

__device__ __forceinline__ void hg_out_stage(int bh, int c, const bf16_t* PROJ, const bf16_t* UT, unsigned char* lds) {
    const int tid = threadIdx.x; const int b = bh >> 2, h = bh & 3, unit = bh * 65 + c;
    const size_t m0 = (size_t)b * LP + (size_t)c * 128;
    stage_vT(PROJ, m0, h, (bf16_t*)lds);
    bf16_t* sT = (bf16_t*)(lds + 34816);
#pragma unroll
    for (int ii = 0; ii < 4; ++ii) { const int p = tid + 512 * ii, s = p >> 4, vc = p & 15;
        const u32x4 e = *(const u32x4*)(UT + (size_t)unit * 16384 + s * 128 + vc * 8); *(u32x4*)(sT + s * 136 + vc * 8) = e; }
}
__device__ __forceinline__ void hg_out_wave(int bh, int c, int i, const bf16_t* KH, const bf16_t* QT, const bf16_t* QB, const float* DB, const bf16_t* PROJ, const float* hgn, bf16_t* MIX, const unsigned char* lds) {
    const int lane = threadIdx.x & 63, r = lane & 15, quad = lane >> 4;
    const int b = bh >> 2, h = bh & 3, unit = bh * 65 + c;
    const size_t m0 = (size_t)b * LP + (size_t)c * 128;
    const bf16_t* vT = (const bf16_t*)lds; const bf16_t* sT = (const bf16_t*)(lds + 34816);
    const size_t mt = m0 + 16 * i + r; const int kc = h * 128 + quad * 8;
    const bf16_t* KHl = KH + (m0 + r) * 512 + kc;
    const float* DBl = DB + (size_t)unit * 1024 + quad * 8;
    bf16x8 qtl[4], qbr[4]; float g[4][8]; u32x4 khn[4]; f32x4 dn[4][2];
#pragma unroll
    for (int ks = 0; ks < 4; ++ks) { qtl[ks] = *(const bf16x8*)(QT + mt * 512 + kc + 32 * ks); qbr[ks] = *(const bf16x8*)(QB + mt * 512 + kc + 32 * ks);
        khn[ks] = *(const u32x4*)(KHl + (size_t)(16 * i) * 512 + 32 * ks);
        const float* dp = DBl + i * 128 + 32 * ks; dn[ks][0] = *(const f32x4*)dp; dn[ks][1] = *(const f32x4*)(dp + 4); }
    f32x4 o[8];
#pragma unroll
    for (int vt = 0; vt < 8; ++vt) o[vt] = (f32x4){0.f, 0.f, 0.f, 0.f};
    f32x4 scA = (f32x4){0.f, 0.f, 0.f, 0.f}, scB = scA; int jA = i;
    for (int jb = i; jb >= 0; --jb) {
        const int mode = (jb == i) ? 0 : ((jb == i - 1) ? 1 : 2);
        u32x4 kh[4];
#pragma unroll
        for (int ks = 0; ks < 4; ++ks) { kh[ks] = khn[ks];
            if (mode == 0) {
#pragma unroll
                for (int j = 0; j < 4; ++j) { g[ks][j] = __builtin_amdgcn_rcpf(fmaxf(dn[ks][0][j], 1e-30f)); g[ks][4 + j] = __builtin_amdgcn_rcpf(fmaxf(dn[ks][1][j], 1e-30f)); } }
            else if (mode == 2) {
#pragma unroll
                for (int j = 0; j < 4; ++j) { g[ks][j] *= dn[ks][0][j]; g[ks][4 + j] *= dn[ks][1][j]; } } }
        if (jb > 0) {
#pragma unroll
            for (int ks = 0; ks < 4; ++ks) { khn[ks] = *(const u32x4*)(KHl + (size_t)(16 * (jb - 1)) * 512 + 32 * ks);
                const float* dp = DBl + jb * 128 + 32 * ks; dn[ks][0] = *(const f32x4*)dp; dn[ks][1] = *(const f32x4*)(dp + 4); } }
        f32x4 sc = (f32x4){0.f, 0.f, 0.f, 0.f};
#pragma unroll
        for (int ks = 0; ks < 4; ++ks) { u32x4 t = kh[ks];
            if (mode != 1) {
#pragma unroll
                for (int j = 0; j < 4; ++j) t[j] = cvtpk(bflo(kh[ks][j]) * g[ks][2 * j], bfhi(kh[ks][j]) * g[ks][2 * j + 1]); }
            sc = __builtin_amdgcn_mfma_f32_16x16x32_bf16(__builtin_bit_cast(bf16x8, t), qtl[ks], sc, 0, 0, 0); }
        if (mode == 0) {
#pragma unroll
            for (int jj = 0; jj < 4; ++jj) if (quad * 4 + jj > r) sc[jj] = 0.f;
#pragma unroll
            for (int ks = 0; ks < 4; ++ks)
#pragma unroll
                for (int j = 0; j < 8; ++j) g[ks][j] = 1.0f; }
        const bool second = ((i - jb) & 1) != 0;
        if (!second) { scA = sc; jA = jb; scB = (f32x4){0.f, 0.f, 0.f, 0.f}; } else scB = sc;
        if (second || jb == 0) {
            u32x4 pp; pp.x = cvtpk(scA[0], scA[1]); pp.y = cvtpk(scA[2], scA[3]); pp.z = cvtpk(scB[0], scB[1]); pp.w = cvtpk(scB[2], scB[3]);
            const bf16x8 pf = __builtin_bit_cast(bf16x8, pp);
            const int cA = 16 * jA + quad * 4, cB = 16 * jb + quad * 4;
#pragma unroll
            for (int vt = 0; vt < 8; ++vt) { const bf16_t* vp = vT + (16 * vt + r) * 136;
                const u32x2 a0 = *(const u32x2*)(vp + cA), a1 = *(const u32x2*)(vp + cB); u32x4 av; av.x = a0.x; av.y = a0.y; av.z = a1.x; av.w = a1.y;
                o[vt] = __builtin_amdgcn_mfma_f32_16x16x32_bf16(__builtin_bit_cast(bf16x8, av), pf, o[vt], 0, 0, 0); }
        }
    }
#pragma unroll
    for (int ks = 0; ks < 4; ++ks)
#pragma unroll
        for (int vt = 0; vt < 8; ++vt) { const bf16x8 sf = *(const bf16x8*)(sT + (16 * vt + r) * 136 + 32 * ks + quad * 8); o[vt] = __builtin_amdgcn_mfma_f32_16x16x32_bf16(sf, qbr[ks], o[vt], 0, 0, 0); }
    float ss = 0.f;
#pragma unroll
    for (int vt = 0; vt < 8; ++vt) ss += (o[vt][0] * o[vt][0] + o[vt][1] * o[vt][1]) + (o[vt][2] * o[vt][2] + o[vt][3] * o[vt][3]);
    ss += __shfl_xor(ss, 16); ss += __shfl_xor(ss, 32);
    const float rstd = __builtin_amdgcn_rsqf(ss * (1.0f / 128.0f) + EPS);
    const bf16_t* gp = PROJ + mt * PW + 2560 + h * 128 + quad * 4;
    bf16_t* op = MIX + ((size_t)b * SEQ + (size_t)c * 128 - 128 + 16 * i + r) * D + 512 + h * 128 + quad * 4;
#pragma unroll
    for (int vt = 0; vt < 8; ++vt) { const u32x2 gw = *(const u32x2*)(gp + 16 * vt); const f32x4 gn = *(const f32x4*)(hgn + h * 128 + 16 * vt + quad * 4);
        const float g0 = bflo(gw.x), g1 = bfhi(gw.x), g2 = bflo(gw.y), g3 = bfhi(gw.y);
        u32x2 ow; ow.x = cvtpk(o[vt][0] * rstd * gn[0] * (g0 * __builtin_amdgcn_rcpf(1.0f + __expf(-g0))), o[vt][1] * rstd * gn[1] * (g1 * __builtin_amdgcn_rcpf(1.0f + __expf(-g1))));
        ow.y = cvtpk(o[vt][2] * rstd * gn[2] * (g2 * __builtin_amdgcn_rcpf(1.0f + __expf(-g2))), o[vt][3] * rstd * gn[3] * (g3 * __builtin_amdgcn_rcpf(1.0f + __expf(-g3))));
        *(u32x2*)(op + 16 * vt) = ow; }
}

#define LAS __attribute__((address_space(3)))
#define XB_TMO      128
#define XB_XCNT(j)  (256  + 64 * (j))
#define XB_XSUB(j)  (1280 + 64 * (j))
#define XB_XGEN(j)  (2304 + 64 * (j))
#define XB_TOP      3328
#define XB_TOPGEN   3392
#define XCD_BAR_WORDS 3456
#define XB_SPIN_CAP (1u << 18)

__device__ __forceinline__ unsigned xb_ld(unsigned* p)              { return __hip_atomic_load(p, __ATOMIC_RELAXED, __HIP_MEMORY_SCOPE_AGENT); }
__device__ __forceinline__ unsigned xb_add(unsigned* p, unsigned v) { return __hip_atomic_fetch_add(p, v, __ATOMIC_RELAXED, __HIP_MEMORY_SCOPE_AGENT); }
__device__ __forceinline__ unsigned xb_xcc_id() { return (unsigned)__builtin_amdgcn_s_getreg((3 << 11) | 20) & 0xFu; }
#define XB_SPIN(cond, bar) do { unsigned _sp = 0; while (cond) { __builtin_amdgcn_s_sleep(1); \
    if ((++_sp & 255u) == 0u) { if (xb_ld(&(bar)[XB_TMO])) break; if (_sp > XB_SPIN_CAP) { atomicAdd(&(bar)[XB_TMO], 1u); break; } } } } while (0)

struct XcdBarrier {
    unsigned* bar; unsigned x;
    volatile LAS unsigned* st;
};

__device__ __forceinline__ XcdBarrier xcd_barrier_post(unsigned* bar, volatile LAS unsigned* st) {
    XcdBarrier b; b.bar = bar; b.x = xb_xcc_id(); b.st = st;
    if (threadIdx.x == 0) (void)xb_add(&bar[XB_XCNT(b.x)], 1u);
    return b;
}
__device__ __forceinline__ void xcd_barrier_complete(unsigned* bar, unsigned x, unsigned& nloc, unsigned& nx) {
    const unsigned G = gridDim.x * gridDim.y * gridDim.z;
    unsigned sum, cnt, mine, sp = 0u;
    for (;;) {
        sum = 0u; cnt = 0u; mine = 0u;
#pragma unroll
        for (unsigned j = 0; j < 16; ++j) { const unsigned c = xb_ld(&bar[XB_XCNT(j)]); sum += c; cnt += (c > 0u) ? 1u : 0u; mine = (j == x) ? c : mine; }
        if (sum == G) break;
        __builtin_amdgcn_s_sleep(1);
        if ((++sp & 255u) == 0u) { if (xb_ld(&bar[XB_TMO])) break; if (sp > XB_SPIN_CAP) { atomicAdd(&bar[XB_TMO], 1u); break; } }
    }
    nloc = mine > 0u ? mine : 1u; nx = cnt > 0u ? cnt : 1u;
}

__device__ __forceinline__ void xcd_barrier(const XcdBarrier& b) {
    asm volatile("s_waitcnt vmcnt(0)" ::: "memory");
    __syncthreads();
    if (threadIdx.x == 0) {
        unsigned* bar = b.bar;
        __builtin_amdgcn_s_waitcnt(0);
        unsigned nloc = b.st[0], nx = b.st[1];
        if (nloc == 0u) { xcd_barrier_complete(bar, b.x, nloc, nx); b.st[0] = nloc; b.st[1] = nx; }
        const unsigned old = xb_add(&bar[XB_XSUB(b.x)], 1u);
        const unsigned gen = old / nloc;
        if (old + 1u == (gen + 1u) * nloc) {
            __builtin_amdgcn_fence(__ATOMIC_RELEASE, "agent");
            asm volatile("s_waitcnt vmcnt(0)" ::: "memory");
            const unsigned og = xb_add(&bar[XB_TOP], 1u);
            const unsigned tg = og / nx;
            if (og + 1u == (tg + 1u) * nx) xb_add(&bar[XB_TOPGEN], 1u);
            else XB_SPIN(xb_ld(&bar[XB_TOPGEN]) == tg, bar);
            __builtin_amdgcn_fence(__ATOMIC_ACQUIRE, "agent");
            xb_add(&bar[XB_XGEN(b.x)], 1u);
            asm volatile("s_waitcnt vmcnt(0)" ::: "memory");
        } else {
            XB_SPIN(xb_ld(&bar[XB_XGEN(b.x)]) == gen, bar);
            __builtin_amdgcn_fence(__ATOMIC_ACQUIRE, "agent");
            asm volatile("s_waitcnt vmcnt(0)" ::: "memory");
        }
    }
    __syncthreads();
}

#ifndef PROBE_PHASE
#define PROBE_PHASE -1
#endif
#define PHT0(k) unsigned long long pt0_ = 0; if (PROBE_PHASE == (k)) pt0_ = __builtin_amdgcn_s_memrealtime()
#define PHT1(k) do { if (PROBE_PHASE == (k)) { const unsigned long long pt1_ = __builtin_amdgcn_s_memrealtime(), pd_ = pt1_ - pt0_; while (__builtin_amdgcn_s_memrealtime() - pt1_ < pd_) __builtin_amdgcn_s_sleep(8); } } while (0)
#ifndef REP_HL
#define REP_HL 1
#endif
#ifndef REP_AT
#define REP_AT 1
#endif
#ifndef REP_P2C
#define REP_P2C 1
#endif
#ifndef REP_SYNC
#define REP_SYNC 1
#endif
#ifndef REP_P0
#define REP_P0 1
#endif
#ifndef REP_P3
#define REP_P3 1
#endif
#ifndef REP_P5
#define REP_P5 1
#endif
#ifndef REP_P2B
#define REP_P2B 1
#endif
#ifndef REP_P1
#define REP_P1 1
#endif
#ifndef REP_P4
#define REP_P4 1
#endif
#define GSYNC() do { for (int rs_ = 0; rs_ < REP_SYNC; ++rs_) xcd_barrier(xbar); } while (0)
struct Args { const float* in[13]; float* out; unsigned char* ws; long long pad; };
__global__ void __launch_bounds__(512, 2) hybrid_fwd(Args a) {
    extern __shared__ __attribute__((aligned(16))) unsigned char lds[];
    cg::grid_group grid = cg::this_grid();
    const int tid = threadIdx.x, lane = tid & 63, wave = __builtin_amdgcn_readfirstlane(tid >> 6);
    const int G = gridDim.x, bx = blockIdx.x;
    typedef const __attribute__((address_space(4))) unsigned char* kptr_t;
    kptr_t kp = (kptr_t)__builtin_amdgcn_kernarg_segment_ptr();
#define KIN(i) (*(const float* const __attribute__((address_space(4)))*)(kp + 8 * (i)))
#define PH_BEGIN() asm volatile("" : "+s"(kp)); unsigned char* const ws = *(unsigned char* const __attribute__((address_space(4)))*)(kp + 112)
#define W_BF(off) ((bf16_t*)(ws + (off)))
#define W_F32(off) ((float*)(ws + (off)))
    volatile LAS unsigned* bst = (volatile LAS unsigned*)((LAS unsigned char*)lds + LDS_BYTES - 64);
    if (tid == 0) { bst[0] = 0u; bst[1] = 0u; }
    __syncthreads();
    const XcdBarrier xbar = xcd_barrier_post((unsigned*)a.ws, bst);
    PG8_LAS unsigned char* ldsp = (PG8_LAS unsigned char*)lds;

    { PHT0(0);
    {
        PH_BEGIN(); const float *x = KIN(0), *meta = KIN(1), *n1g = KIN(2), *w_in = KIN(3);
        bf16_t *Win_t = W_BF(WS_WIN), *U = W_BF(WS_U);
        float* scr = (float*)(lds + wave * 16384);
        const int gw = bx * 8 + wave, NGW = G * 8;
        constexpr int I_IN = (D / 64) * (INW / 32);
        constexpr int NGRP = MP / 4;
        f32x4 va[4][4], vb[4][4]; const int g0 = gw, g1 = gw + NGW, g2 = gw + 2 * NGW;
        if (g0 < NGRP) u_load4(4 * g0, x, meta, va, lane);
        if (g1 < NGRP) u_load4(4 * g1, x, meta, vb, lane);
        if (g0 < NGRP) u_finish4(4 * g0, va, n1g, U, lane);
        if (g1 < NGRP) u_finish4(4 * g1, vb, n1g, U, lane);
        for (int g = g2; g < NGRP; g += NGW) { u_load4(4 * g, x, meta, va, lane); u_finish4(4 * g, va, n1g, U, lane); }
        t_run(gw, I_IN, NGW, [&](int it) { return TItem{w_in, Win_t, nullptr, D, INW, 0, it}; }, scr, lane);
    }
    if (a.pad != 0) grid.sync();
    GSYNC(); PHT1(0); }
    { PHT0(1);
    {
        PH_BEGIN(); const float* lbl = KIN(6); bf16_t *U = W_BF(WS_U), *Win_t = W_BF(WS_WIN), *PROJ = W_BF(WS_PROJ); float* LOGF = W_F32(WS_LOGF);
        pg8::Gemm g{U, Win_t, MP, INW, D}; pg8::StaticOrder S; S.init(MP, INW, G, bx); S.rep = REP_P1;
        pg8::EpiProj E{PROJ, LOGF, lbl};
        pg8::gemm_phase<pg8::EpiProj, pg8::StaticOrder, true, true>(ldsp, g, S, E);
    }
    GSYNC(); PHT1(1); }
    { PHT0(2);
    {
        PH_BEGIN(); const float* sbn = KIN(4); bf16_t *PROJ = W_BF(WS_PROJ), *UT = W_BF(WS_UT), *MIX = W_BF(WS_MIX); float *LOGF = W_F32(WS_LOGF), *DB = W_F32(WS_U), *DEC = W_F32(WS_SMALL);
        bf16_t* KH = *(bf16_t* const __attribute__((address_space(4)))*)(kp + 104); bf16_t *QT = KH + (size_t)MP * 512, *QB = KH + (size_t)MP * 1024;
        for (int uu = bx; uu < 512 * REP_HL; uu += G) hg_local_unit(((uu >> 6) & 7) * 65 + (uu & 63), false, LOGF, PROJ, KH, QT, QB, DB, UT, DEC, (unsigned*)(ws + 32768), lds);
        for (int uu = bx; uu < 8; uu += G) hg_local_unit(uu * 65 + 64, true, LOGF, PROJ, KH, QT, QB, DB, UT, DEC, (unsigned*)(ws + 32768), lds);
        const int vcu = (G % 8 == 0) ? (bx % 8) * (G / 8) + bx / 8 : bx;
        for (int au = vcu * 8 + wave; au < 4096 * REP_AT; au += G * 8) attn_unit(au & 4095, PROJ, sbn, MIX, (bf16_t*)(lds + 73728 + wave * 4608));
    }
    PHT1(2); }
    { PHT0(3);
    {
        PH_BEGIN(); const bf16_t* __restrict__ UT = W_BF(WS_UT); bf16_t* __restrict__ SP = W_BF(WS_SPREV); const float* __restrict__ DEC = W_F32(WS_SMALL);
        {
            if (bx < 128 && tid == 0) { unsigned* c = (unsigned*)(ws + 32768) + 64 * (bx >> 4); unsigned sp = 0;
                while (__hip_atomic_load(c, __ATOMIC_RELAXED, __HIP_MEMORY_SCOPE_AGENT) < 65u) { __builtin_amdgcn_s_sleep(2); if (++sp > (1u << 22)) break; }
                __builtin_amdgcn_fence(__ATOMIC_ACQUIRE, "agent"); asm volatile("s_waitcnt vmcnt(0)" ::: "memory"); }
            __syncthreads();
        }
        for (int rb = 0; rb < REP_P2B; ++rb) {
        const int gid = bx * 512 + tid;
        if (gid < 65536) { const int bh = gid >> 13, e2 = gid & 8191, k2 = (2 * e2) & 127;
            float s0 = 0.f, s1 = 0.f;
            for (int c0 = 0; c0 < 64; c0 += 32) {
                unsigned uu[32]; float d0[32], d1[32];
#pragma unroll
                for (int j = 0; j < 32; ++j) { const int unit = bh * 65 + c0 + j; uu[j] = *((const unsigned*)(UT + (size_t)unit * 16384) + e2);
                    const float2 dd = *(const float2*)(DEC + unit * 128 + k2); d0[j] = dd.x; d1[j] = dd.y; }
#pragma unroll
                for (int j = 0; j < 32; ++j) { const int unit = bh * 65 + c0 + j; __hip_atomic_store((unsigned*)(SP + (size_t)unit * 16384) + e2, cvtpk(s0, s1), __ATOMIC_RELAXED, __HIP_MEMORY_SCOPE_AGENT);
                    s0 = d0[j] * s0 + bflo(uu[j]); s1 = d1[j] * s1 + bfhi(uu[j]); }
            }
            __hip_atomic_store((unsigned*)(SP + (size_t)(bh * 65 + 64) * 16384) + e2, cvtpk(s0, s1), __ATOMIC_RELAXED, __HIP_MEMORY_SCOPE_AGENT);
        }
        }
        if (bx < 128) {
            asm volatile("s_waitcnt vmcnt(0)" ::: "memory"); __syncthreads();
            if (tid == 0) __hip_atomic_fetch_add((unsigned*)(ws + 32768 + 2048) + 64 * (bx >> 4), 1u, __ATOMIC_RELAXED, __HIP_MEMORY_SCOPE_AGENT);
        }
        {
            const float *w_out = KIN(7), *n2g = KIN(8), *w_gate = KIN(9), *w_up = KIN(10), *w_down = KIN(11);
            bf16_t *Wout_t = W_BF(WS_WOUT), *Wgu_t = W_BF(WS_WGU), *Wdn_t = W_BF(WS_WDN);
            float* scr = (float*)(lds + wave * 16384);
            constexpr int I_OUT = (D / 64) * (D / 32), I_G = (D / 64) * (FF / 32), I_DN = (FF / 64) * (D / 32), NREM = I_OUT + 2 * I_G + I_DN, NIDLE = 3 * 1024;
            const bool idle = bx >= 128; const int idx = (idle ? bx - 128 : bx) * 8 + wave;
            t_run((idle ? 0 : NIDLE) + idx, idle ? NIDLE : NREM, 1024, [&](int it) { int r = it;
                if (r < I_OUT) return TItem{w_out, Wout_t, nullptr, D, D, 0, r}; r -= I_OUT;
                if (r < I_G) return TItem{w_gate, Wgu_t, n2g, D, FF, 1, r}; r -= I_G;
                if (r < I_G) return TItem{w_up, Wgu_t, n2g, D, FF, 2, r}; r -= I_G;
                return TItem{w_down, Wdn_t, nullptr, FF, D, 0, r}; }, scr, lane);
        }
    }
    PHT1(3); }
    { PHT0(4);
    {
        PH_BEGIN(); const float* hgn = KIN(5); bf16_t *PROJ = W_BF(WS_PROJ), *UT = W_BF(WS_SPREV), *MIX = W_BF(WS_MIX); const float* DB = W_F32(WS_U);
        const bf16_t* KH = *(bf16_t* const __attribute__((address_space(4)))*)(kp + 104); const bf16_t *QT = KH + (size_t)MP * 512, *QB = KH + (size_t)MP * 1024;
        for (int rr = 0; rr < REP_P2C; ++rr) {
            const int bhA = bx >> 6, bhB = 4 + (bx >> 6), cc = (bx & 63) + 1;
            if (tid == 0) { unsigned* c = (unsigned*)(ws + 32768 + 2048); unsigned sp = 0;
                while (__hip_atomic_load(c + 64 * bhA, __ATOMIC_RELAXED, __HIP_MEMORY_SCOPE_AGENT) < 16u || __hip_atomic_load(c + 64 * bhB, __ATOMIC_RELAXED, __HIP_MEMORY_SCOPE_AGENT) < 16u) { __builtin_amdgcn_s_sleep(2); if (++sp > (1u << 22)) break; }
                __builtin_amdgcn_fence(__ATOMIC_ACQUIRE, "agent"); asm volatile("s_waitcnt vmcnt(0)" ::: "memory"); }
            __syncthreads();
            hg_out_stage(bhA, cc, PROJ, UT, lds); hg_out_stage(bhB, cc, PROJ, UT, lds + 69632);
            __syncthreads();
            hg_out_wave(bhA, cc, wave, KH, QT, QB, DB, PROJ, hgn, MIX, lds);
            hg_out_wave(bhB, cc, 7 - wave, KH, QT, QB, DB, PROJ, hgn, MIX, lds + 69632);
            __syncthreads();
        }
    }
    GSYNC(); PHT1(4); }
    { PHT0(5);
    {
        PH_BEGIN(); const float* x = KIN(0); float* out = *(float* const __attribute__((address_space(4)))*)(kp + 104); bf16_t *MIX = W_BF(WS_MIX), *Wout_t = W_BF(WS_WOUT), *H2B = W_BF(WS_LOGF); float* SS2 = W_F32(WS_SMALL + 512 * 1024);
        pg8::Gemm g{MIX, Wout_t, MX, D, D}; pg8::StaticOrder S; S.init(MX, D, G, bx); S.rep = REP_P3;
        pg8::EpiResid E{x, nullptr, H2B, SS2};
        pg8::gemm_phase<pg8::EpiResid, pg8::StaticOrder, false, true>(ldsp, g, S, E);
    }
    GSYNC(); PHT1(5); }
    { PHT0(6);
    {
        PH_BEGIN(); bf16_t *H2B = W_BF(WS_LOGF), *Wgu_t = W_BF(WS_WGU), *HID = W_BF(WS_PROJ); float* SS2 = W_F32(WS_SMALL + 512 * 1024);
        pg8::Gemm g{H2B, Wgu_t, MX, 2 * FF, D}; pg8::StaticOrder S; S.init(MX, 2 * FF, G, bx); S.rep = REP_P4;
        pg8::EpiSwiglu E{HID, SS2};
        pg8::gemm_phase<pg8::EpiSwiglu, pg8::StaticOrder, true, true>(ldsp, g, S, E);
    }
    GSYNC(); PHT1(6); }
    { PHT0(7);
    {
        PH_BEGIN(); const float* fng = KIN(12); float* out = *(float* const __attribute__((address_space(4)))*)(kp + 104); bf16_t *HID = W_BF(WS_PROJ), *Wdn_t = W_BF(WS_WDN); float* SS3 = W_F32(WS_SMALL + 768 * 1024);
        pg8::Gemm g{HID, Wdn_t, MX, D, FF}; pg8::StaticOrder S; S.init(MX, D, G, bx); S.rep = REP_P5;
        pg8::EpiFinal E{W_BF(WS_LOGF), out, SS3, (unsigned*)(ws + 16384), fng};
        pg8::gemm_phase<pg8::EpiFinal, pg8::StaticOrder, false, true>(ldsp, g, S, E);
    }
    PHT1(7); }
}

extern "C" void kernel_launch(void* const* d_in, const int* in_sizes, int n_in, void* d_out, int out_size, void* d_ws, size_t ws_size, hipStream_t stream) {
    static int ready = 0;
    if (!ready) {
        if (n_in != 13 || out_size != MX * D || ws_size < 242 * MiB) { fprintf(stderr, "kernel_launch: unexpected problem shape (n_in %d, out %d, ws %zu)\n", n_in, out_size, ws_size); ready = -1; return; }
        if (hipFuncSetAttribute((const void*)hybrid_fwd, hipFuncAttributeMaxDynamicSharedMemorySize, LDS_BYTES) != hipSuccess) { fprintf(stderr, "kernel_launch: hipFuncSetAttribute failed\n"); ready = -1; return; }
        ready = 1;
    }
    if (ready < 0) return;
    Args a{};
    for (int i = 0; i < 13; ++i) a.in[i] = (const float*)d_in[i];
    a.out = (float*)d_out; a.ws = (unsigned char*)d_ws; a.pad = 0;
    if (hipMemsetAsync(d_ws, 0, 36864, stream) != hipSuccess) { fprintf(stderr, "kernel_launch: memset failed\n"); return; }
    void* args[] = {&a};
    const hipError_t e = hipLaunchCooperativeKernel((const void*)hybrid_fwd, dim3(NWG), dim3(512), args, LDS_BYTES, stream);
    if (e != hipSuccess) fprintf(stderr, "kernel_launch: cooperative launch failed: %s\n", hipGetErrorString(e));
}
```
